# Optimizing an MI355X kernel written in HIP

```python
import math
import jax, jax.numpy as jnp
from jax import lax
import numpy as np

D_MODEL = 1024
BATCH = 2
SEQ = 8192
DEPTH = 4

HEAD_DIM = 64
D_ATTN = 512
N_ATTN_HEADS = D_ATTN // HEAD_DIM
D_SGU = 512
N_SGU_GROUPS = 4
SGU_GROUP_DIM = D_SGU // N_SGU_GROUPS
CHUNK = 128
D_MIX = D_ATTN + D_SGU
D_IN = 3 * D_ATTN + 2 * D_SGU
D_FF = 2816
DILATED_PATTERNS = ((128, 1), (512, 4), (2048, 16))
ROPE_THETA = 500000.0
ROPE_DIM = HEAD_DIM // 4
EPS = 1e-6
NEG_INF = -1e30

kernel_name = "hybrid_dilated_attn_sgu_macaron"


def rms_norm(x, g):
    xf = x.astype(jnp.float32)
    y = xf * lax.rsqrt(jnp.mean(xf * xf, axis=-1, keepdims=True) + EPS)
    return (y * g.astype(jnp.float32)).astype(x.dtype)


def layer_norm(x, g, b):
    xf = x.astype(jnp.float32)
    mu = jnp.mean(xf, axis=-1, keepdims=True)
    xc = xf - mu
    y = xc * lax.rsqrt(jnp.mean(xc * xc, axis=-1, keepdims=True) + EPS)
    return (y * g.astype(jnp.float32) + b.astype(jnp.float32)).astype(x.dtype)


def swiglu(h, w_gate, w_up, w_down):
    return (jax.nn.silu(h @ w_gate) * (h @ w_up)) @ w_down


def partial_rotary(x, positions):
    half = ROPE_DIM // 2
    inv_freq = ROPE_THETA ** (-jnp.arange(0, ROPE_DIM, 2, dtype=jnp.float32) / ROPE_DIM)
    ang = positions.astype(jnp.float32)[:, None] * inv_freq[None, :]
    cos, sin = jnp.cos(ang), jnp.sin(ang)
    xr = x[..., :ROPE_DIM].astype(jnp.float32)
    x1, x2 = xr[..., :half], xr[..., half:]
    rot = jnp.concatenate([x1 * cos - x2 * sin, x1 * sin + x2 * cos], axis=-1)
    return jnp.concatenate([rot.astype(x.dtype), x[..., ROPE_DIM:]], axis=-1)


def banded_attention(q, k, v, half):
    *lead, L, Dh = q.shape
    blk = half
    nb = -(-L // blk)
    pad = nb * blk - L
    lead_pad = [(0, 0)] * len(lead)

    def blocks(t):
        t = jnp.pad(t, lead_pad + [(0, pad), (0, 0)])
        return t.reshape(*lead, nb, blk, Dh)

    def windows(t):
        tp = jnp.pad(t, lead_pad + [(1, 1), (0, 0), (0, 0)])
        return jnp.concatenate([tp[..., :-2, :, :], tp[..., 1:-1, :, :], tp[..., 2:, :, :]], axis=-2)

    qb = blocks(q)
    kw = windows(blocks(k))
    vw = windows(blocks(v))
    s = jnp.einsum("...nqd,...nkd->...nqk", qb, kw).astype(jnp.float32) * (1.0 / math.sqrt(Dh))
    n = jnp.arange(nb)[:, None, None]
    qi = n * blk + jnp.arange(blk)[None, :, None]
    ki = (n - 1) * blk + jnp.arange(3 * blk)[None, None, :]
    mask = (jnp.abs(ki - qi) <= half) & (ki >= 0) & (ki < L)
    s = jnp.where(mask, s, NEG_INF)
    lse = jax.nn.logsumexp(s, axis=-1)
    p = jnp.exp(s - lse[..., None])
    o = jnp.einsum("...nqk,...nkd->...nqd", p.astype(v.dtype), vw)
    o = o.reshape(*lead, nb * blk, Dh)[..., :L, :]
    lse = lse.reshape(*lead, nb * blk)[..., :L]
    return o, lse


def dilated_attention(q, k, v):
    B, H, S, Dh = q.shape
    outs, lses = [], []
    for window, dil in DILATED_PATTERNS:
        half = window // 2 // dil

        def to_strided(t):
            return t.reshape(B, H, S // dil, dil, Dh).swapaxes(2, 3)

        o, l = banded_attention(to_strided(q), to_strided(k), to_strided(v), half)
        outs.append(o.swapaxes(2, 3).reshape(B, H, S, Dh))
        lses.append(l.swapaxes(2, 3).reshape(B, H, S))
    w = jax.nn.softmax(jnp.stack(lses, axis=0), axis=0)
    out = jnp.einsum("pbhs,pbhsd->bhsd", w, jnp.stack(outs, axis=0).astype(jnp.float32))
    return out.astype(q.dtype)


def spatial_gating(u, v, ln_g, ln_b, w_s, b_s):
    B, S, _ = v.shape
    u = jax.nn.gelu(u, approximate=False)
    v = layer_norm(jax.nn.gelu(v, approximate=False), ln_g, ln_b)
    vc = v.reshape(B, S // CHUNK, CHUNK, N_SGU_GROUPS, SGU_GROUP_DIM)
    mixed = jnp.einsum("gts,bcsge->bctge", w_s, vc) + b_s.T[None, None, :, :, None]
    return u * mixed.reshape(B, S, D_SGU)


def setup_inputs(seed: int = 0) -> dict:
    key = jax.random.key(seed)
    ks = jax.random.split(key, 20)
    f32 = jnp.float32

    def nrm(k, shape, scale):
        return jax.random.normal(k, shape, f32) * scale

    def gain(k, shape):
        return 1.0 + 0.02 * jax.random.normal(k, shape, f32)

    L = DEPTH
    return {
        "x": jax.random.normal(ks[0], (BATCH, SEQ, D_MODEL), f32),
        "norm_ffn1": gain(ks[1], (L, D_MODEL)),
        "ffn1_w_gate": nrm(ks[2], (L, D_MODEL, D_FF), D_MODEL ** -0.5),
        "ffn1_w_up": nrm(ks[3], (L, D_MODEL, D_FF), D_MODEL ** -0.5),
        "ffn1_w_down": nrm(ks[4], (L, D_FF, D_MODEL), D_FF ** -0.5),
        "norm_mix": gain(ks[5], (L, D_MODEL)),
        "w_in": nrm(ks[6], (L, D_MODEL, D_IN), D_MODEL ** -0.5),
        "sgu_ln_g": gain(ks[7], (L, D_SGU)),
        "sgu_ln_b": nrm(ks[8], (L, D_SGU), 0.02),
        "sgu_w": nrm(ks[9], (L, N_SGU_GROUPS, CHUNK, CHUNK), 0.5 * CHUNK ** -0.5),
        "sgu_b": gain(ks[10], (L, N_SGU_GROUPS, CHUNK)),
        "out_norm_attn": gain(ks[11], (L, D_ATTN)),
        "out_norm_sgu": gain(ks[12], (L, D_SGU)),
        "w_out": nrm(ks[13], (L, D_MIX, D_MODEL), D_MIX ** -0.5),
        "norm_ffn2": gain(ks[14], (L, D_MODEL)),
        "ffn2_w_gate": nrm(ks[15], (L, D_MODEL, D_FF), D_MODEL ** -0.5),
        "ffn2_w_up": nrm(ks[16], (L, D_MODEL, D_FF), D_MODEL ** -0.5),
        "ffn2_w_down": nrm(ks[17], (L, D_FF, D_MODEL), D_FF ** -0.5),
        "final_norm": gain(ks[18], (D_MODEL,)),
    }


def reference(x, norm_ffn1, ffn1_w_gate, ffn1_w_up, ffn1_w_down, norm_mix, w_in,
              sgu_ln_g, sgu_ln_b, sgu_w, sgu_b, out_norm_attn, out_norm_sgu, w_out,
              norm_ffn2, ffn2_w_gate, ffn2_w_up, ffn2_w_down, final_norm):
    B, S, _ = x.shape
    positions = jnp.arange(S, dtype=jnp.int32)
    splits = [D_ATTN, 2 * D_ATTN, 3 * D_ATTN, 3 * D_ATTN + D_SGU]

    def heads(t):
        return t.reshape(B, S, N_ATTN_HEADS, HEAD_DIM).transpose(0, 2, 1, 3)

    for l in range(DEPTH):
        x = x + 0.5 * swiglu(rms_norm(x, norm_ffn1[l]), ffn1_w_gate[l], ffn1_w_up[l], ffn1_w_down[l])

        h = rms_norm(x, norm_mix[l])
        proj = h @ w_in[l]
        q, k, v, u, g = jnp.split(proj, splits, axis=-1)
        q = partial_rotary(heads(q), positions)
        k = partial_rotary(heads(k), positions)
        a = dilated_attention(q, k, heads(v))
        a = a.transpose(0, 2, 1, 3).reshape(B, S, D_ATTN)
        sg = spatial_gating(u, g, sgu_ln_g[l], sgu_ln_b[l], sgu_w[l], sgu_b[l])
        mixed = jnp.concatenate([rms_norm(a, out_norm_attn[l]), rms_norm(sg, out_norm_sgu[l])], axis=-1)
        x = x + mixed @ w_out[l]

        x = x + 0.5 * swiglu(rms_norm(x, norm_ffn2[l]), ffn2_w_gate[l], ffn2_w_up[l], ffn2_w_down[l])

    return rms_norm(x, final_norm)
```

```cpp
#include <hip/hip_runtime.h>
#include <hip/hip_cooperative_groups.h>
#include <cstdio>
#include <cstdint>
namespace cg = cooperative_groups;

#ifndef SKIP
#define SKIP 0
#endif
#ifndef DUP
#define DUP 0
#endif
#ifndef FUSE_FINAL
#define FUSE_FINAL 1
#endif
#ifndef MK_ONE
#define MK_ONE 1
#endif

namespace pg8 {
#define PG8_LAS __attribute__((address_space(3)))
typedef unsigned short bf16_t;
typedef short bf16x8 __attribute__((ext_vector_type(8)));
typedef float f32x4 __attribute__((ext_vector_type(4)));
typedef float f32x2 __attribute__((ext_vector_type(2)));
typedef unsigned u32x4 __attribute__((ext_vector_type(4)));
typedef unsigned u32x2 __attribute__((ext_vector_type(2)));
constexpr int BM = 256, BK = 64, HALF = 128, HTB = HALF * BK * 2, STAGE_BYTES = 8 * HTB, NXCD = 8, WGM = 8;

__host__ __device__ __forceinline__ int lds_byte(int r, int c) { const int st = (r >> 4) * 2 + (c >> 5), rr = r & 15, cc = c & 31, ob = rr * 64 + cc * 2; return st * 1024 + (ob ^ (((ob >> 9) & 1) << 5)); }
__host__ __device__ __forceinline__ void stage_rc(int b, int& R, int& C) { const int st = b / 1024, sb = b % 1024, swz = sb ^ (((sb >> 9) & 1) << 5); R = (st >> 1) * 16 + swz / 64; C = (st & 1) * 32 + (swz % 64) / 2; }
__host__ __device__ __forceinline__ int perm32(int rho) { const int n = rho >> 4, i = rho & 15; return 8 * (i >> 2) + 4 * n + (i & 3); }

struct Unit { int pm, pn; };
struct Gemm { const bf16_t* A; const bf16_t* Bt; int M, N, K; };

struct StaticOrder {
    int nM, nN, nwg, G, c;
    __host__ __device__ void init(int M, int N, int G_, int c_) { nM = M / BM; nN = N / BM; nwg = nM * nN; G = G_; c = c_; }
    __host__ __device__ bool next(int i, Unit& u) const {
        const long L = (long)i * G + c; if (L >= nwg) return false;
        int wgid = (int)L; { const int q = nwg / NXCD, r = nwg % NXCD, xcd = wgid % NXCD, off = wgid / NXCD; wgid = (xcd < r ? xcd * (q + 1) : r * (q + 1) + (xcd - r) * q) + off; }
        const int nig = WGM * nN, gid = wgid / nig, fm = gid * WGM, gsz = (nM - fm) < WGM ? (nM - fm) : WGM;
        u.pm = fm + ((wgid % nig) % gsz); u.pn = (wgid % nig) / gsz; return true;
    }
};

__device__ __forceinline__ unsigned cvt_pk_bf16(float lo, float hi) { unsigned r; asm volatile("v_cvt_pk_bf16_f32 %0, %1, %2" : "=v"(r) : "v"(lo), "v"(hi)); return r; }

__device__ __forceinline__ f32x2 gelu_pk(f32x2 v) {
    const f32x2 av = __builtin_elementwise_abs(v), d = av * 0.2316418882f + 1.0f;
    f32x2 t; t.x = __builtin_amdgcn_rcpf(d.x); t.y = __builtin_amdgcn_rcpf(d.y);
    f32x2 q = t * 0.5307027145f + (-0.7265760135f); q = q * t + 0.7107068705f; q = q * t + (-0.142248368f); q = q * t + 0.127414796f; q = q * t;
    const f32x2 s = (v * v) * (-0.72134752044f);
    f32x2 e; e.x = __builtin_amdgcn_exp2f(s.x); e.y = __builtin_amdgcn_exp2f(s.y);
    const f32x2 m = v * (q * e), r = v - m;
    f32x2 o; o.x = v.x < 0.f ? m.x : r.x; o.y = v.y < 0.f ? m.y : r.y; return o;
}
__device__ __forceinline__ f32x4 gelu4(f32x4 v) { f32x2 a = gelu_pk((f32x2){v[0], v[1]}), b = gelu_pk((f32x2){v[2], v[3]}); return (f32x4){a.x, a.y, b.x, b.y}; }

template <class Epi, class Sched, bool ALIGN_EPI = false>
__device__ __forceinline__ void gemm_phase(PG8_LAS unsigned char* lds, const Gemm g, const Sched& S, const Epi& E) {
    int tid_ = threadIdx.x; asm volatile("" : "+v"(tid_));
    const int tid = tid_, wid = __builtin_amdgcn_readfirstlane(tid >> 6), lane = tid & 63, wr = wid >> 2, wc = wid & 3, fr = lane & 15, fq = lane >> 4;
    const int K = g.K, nt = K / BK;
    unsigned voffA[2], voffB[2];
#pragma unroll
    for (int i = 0; i < 2; ++i) { int R, C; stage_rc(tid * 16 + i * 8192, R, C); const int Rb = Epi::PERM ? ((R & ~31) + perm32(R & 31)) : R;
        voffA[i] = (unsigned)(R * K + C) * 2u; voffB[i] = (unsigned)(Rb * K + C) * 2u; }
    const size_t kstep = (size_t)(BK * 2);
    const size_t hstep = (size_t)HALF * K * 2;
    const size_t tstep = 2 * hstep;
    const unsigned ldsw = (unsigned)wid * 1024u;
    const int aoff = lds_byte(wr * 64 + fr, fq * 8), boff = lds_byte(wc * 32 + fr, fq * 8);
#define PG8_SA(b, h) (((b) * 2 + (h)) * HTB)
#define PG8_SB(b, h) ((4 + (b) * 2 + (h)) * HTB)
#define PG8_STAGE(bufoff, gbase, voff) do { _Pragma("unroll") for (int _i = 0; _i < 2; ++_i) \
        __builtin_amdgcn_global_load_lds((const unsigned*)((const char*)(gbase) + (voff)[_i]), (PG8_LAS unsigned*)(lds + (bufoff) + ldsw + _i * 8192), 16, 0, 0); } while (0)
#define PG8_LDA(dst, b, h) do { _Pragma("unroll") for (int m = 0; m < 4; ++m) _Pragma("unroll") for (int k = 0; k < 2; ++k) dst[m][k] = *(const PG8_LAS bf16x8*)(lds + PG8_SA(b, h) + aoff + m * 2048 + k * 1024); } while (0)
#define PG8_LDB(dst, b, h) do { _Pragma("unroll") for (int n = 0; n < 2; ++n) _Pragma("unroll") for (int k = 0; k < 2; ++k) dst[n][k] = *(const PG8_LAS bf16x8*)(lds + PG8_SB(b, h) + boff + n * 2048 + k * 1024); } while (0)
#define PG8_MMA(ai, bj, At, Bt) do { __builtin_amdgcn_s_setprio(1); _Pragma("unroll") for (int m = 0; m < 4; ++m) _Pragma("unroll") for (int n = 0; n < 2; ++n) _Pragma("unroll") for (int k = 0; k < 2; ++k) \
        acc[ai][bj][m][n] = __builtin_amdgcn_mfma_f32_16x16x32_bf16(Bt[n][k], At[m][k], acc[ai][bj][m][n], 0, 0, 0); __builtin_amdgcn_s_setprio(0); } while (0)
#define PG8_WAIT_V(n) asm volatile("s_waitcnt vmcnt(" #n ")" ::: "memory")
#define PG8_WAIT_L(n) asm volatile("s_waitcnt lgkmcnt(" #n ")" ::: "memory")
#define PG8_BAR __builtin_amdgcn_s_barrier()
#define PG8_SCHED __builtin_amdgcn_sched_barrier(0)
    Unit cur, nxt; int ui = 0;
    if (!S.next(0, cur)) return;
    f32x4 acc[2][2][4][2];
#pragma unroll
    for (int a = 0; a < 2; ++a)
#pragma unroll
        for (int b = 0; b < 2; ++b)
#pragma unroll
            for (int m = 0; m < 4; ++m)
#pragma unroll
                for (int n = 0; n < 2; ++n) acc[a][b][m][n] = (f32x4){0.f, 0.f, 0.f, 0.f};
    bf16x8 At[4][2], B0[2][2], B1[2][2];
    const char* cA = (const char*)g.A + (size_t)cur.pm * tstep; const char* cB = (const char*)g.Bt + (size_t)cur.pn * tstep;
    {
        PG8_STAGE(PG8_SB(0, 0), cB, voffB); PG8_STAGE(PG8_SB(0, 1), cB + hstep, voffB); PG8_STAGE(PG8_SA(0, 0), cA, voffA); PG8_STAGE(PG8_SA(0, 1), cA + hstep, voffA);
        if (wr == 1) PG8_BAR;
        PG8_WAIT_V(2); PG8_BAR;
        PG8_STAGE(PG8_SB(1, 0), cB + kstep, voffB); PG8_STAGE(PG8_SA(1, 0), cA + kstep, voffA); PG8_STAGE(PG8_SB(1, 1), cB + hstep + kstep, voffB);
        PG8_WAIT_V(6); PG8_BAR;
    }
    for (;;) {
        const bool has_next = S.next(ui + 1, nxt);
        const char* nA = has_next ? (const char*)g.A + (size_t)nxt.pm * tstep : cA; const char* nB = has_next ? (const char*)g.Bt + (size_t)nxt.pn * tstep : cB;
        for (int t = 0; t < nt; t += 2) {
            const bool last = (t == nt - 2);
            const char* a1 = cA + (size_t)(t + 1) * kstep;
            const char* a2 = last ? nA : cA + (size_t)(t + 2) * kstep; const char* b2 = last ? nB : cB + (size_t)(t + 2) * kstep;
            const char* a3 = a2 + kstep; const char* b3 = b2 + kstep;
            if constexpr (Epi::MID_T > 0) { if (t == Epi::MID_T) E.mid(acc, cur, wr, fr); }
            PG8_LDB(B0, 0, 0); PG8_LDB(B1, 0, 1); PG8_SCHED; PG8_LDA(At, 0, 0); PG8_STAGE(PG8_SA(1, 1), a1 + hstep, voffA);
            PG8_WAIT_V(8); PG8_WAIT_L(0); PG8_BAR; PG8_MMA(0, 0, At, B0); PG8_MMA(0, 1, At, B1); PG8_BAR; PG8_SCHED;
            PG8_LDA(At, 0, 1); PG8_STAGE(PG8_SB(0, 0), b2, voffB); PG8_STAGE(PG8_SB(0, 1), b2 + hstep, voffB); PG8_STAGE(PG8_SA(0, 0), a2, voffA);
            PG8_WAIT_V(8); PG8_WAIT_L(0); PG8_BAR; PG8_MMA(1, 0, At, B0); PG8_MMA(1, 1, At, B1); PG8_BAR; PG8_SCHED;
            PG8_LDB(B0, 1, 0); PG8_LDB(B1, 1, 1); PG8_SCHED; PG8_LDA(At, 1, 0); PG8_STAGE(PG8_SA(0, 1), a2 + hstep, voffA);
            PG8_WAIT_V(8); PG8_WAIT_L(0); PG8_BAR; PG8_MMA(0, 0, At, B0); PG8_MMA(0, 1, At, B1); PG8_BAR; PG8_SCHED;
            PG8_LDA(At, 1, 1); PG8_STAGE(PG8_SB(1, 0), b3, voffB); PG8_STAGE(PG8_SB(1, 1), b3 + hstep, voffB); PG8_STAGE(PG8_SA(1, 0), a3, voffA);
            PG8_WAIT_V(8); PG8_WAIT_L(0); PG8_BAR; PG8_MMA(1, 0, At, B0); PG8_MMA(1, 1, At, B1); PG8_BAR; PG8_SCHED;
        }
        if constexpr (ALIGN_EPI) { if (wr == 0) PG8_BAR; }
        E(acc, cur, wr, wc, fr, fq, ui);
        if (!has_next) break;
#pragma unroll
        for (int a = 0; a < 2; ++a)
#pragma unroll
            for (int b = 0; b < 2; ++b)
#pragma unroll
                for (int m = 0; m < 4; ++m)
#pragma unroll
                    for (int n = 0; n < 2; ++n) acc[a][b][m][n] = (f32x4){0.f, 0.f, 0.f, 0.f};
        cur = nxt; cA = nA; cB = nB; ++ui;
        if constexpr (ALIGN_EPI) { if (wr == 1) PG8_BAR; }
    }
    PG8_WAIT_V(0);
    if constexpr (!ALIGN_EPI) { if (wr == 0) PG8_BAR; }
    PG8_BAR;
#undef PG8_SA
#undef PG8_SB
#undef PG8_STAGE
#undef PG8_LDA
#undef PG8_LDB
#undef PG8_MMA
#undef PG8_WAIT_V
#undef PG8_WAIT_L
#undef PG8_BAR
#undef PG8_SCHED
}
}

using pg8::bf16_t; using pg8::bf16x8; using pg8::f32x4; using pg8::f32x2; using pg8::u32x4; using pg8::u32x2; using pg8::Unit; using pg8::cvt_pk_bf16;
#define LAS __attribute__((address_space(3)))
#define GAS __attribute__((address_space(1)))
template <class T> __device__ __forceinline__ T* as_global(T* p) { return (T*)(GAS T*)p; }

constexpr int MTOK = 16384, DM = 1024, SEQ = 8192, DFF = 2816, NGU = 2 * DFF, DEPTH = 4, DH = 512;
constexpr float EPS = 1e-6f, LOG2E = 1.4426950408889634f;
constexpr int NWAVES = 8;
constexpr int LDS_BYTES = 147456;

constexpr size_t MiB = 1u << 20;
constexpr size_t WS_STATS = 0;
constexpr size_t WS_ROT = 340 * MiB;
constexpr size_t WS_SGUW = 341 * MiB;
constexpr size_t WS_W = 4 * MiB;
constexpr size_t WL_GU1 = 0, WL_D1 = 11 * MiB, WL_INN = WL_D1 + 5 * MiB + 512 * 1024, WL_INS = WL_INN + 3 * MiB, WL_OUT = WL_INS + 2 * MiB, WL_GU2 = WL_OUT + 2 * MiB, WL_D2 = WL_GU2 + 11 * MiB, WL_STRIDE = 40 * MiB;
static_assert(WL_D2 + 5 * MiB + 512 * 1024 == WL_STRIDE, "weight map");
constexpr size_t WS_XB = 164 * MiB;
constexpr size_t WS_H = 196 * MiB;
constexpr size_t WS_Q = 196 * MiB, WS_K = 212 * MiB, WS_U = 228 * MiB, WS_VT1 = 244 * MiB, WS_VT4 = 260 * MiB, WS_VT16 = 276 * MiB, WS_GT = 292 * MiB, WS_MIX = 308 * MiB, WS_BAR = 342 * MiB, WS_END = 343 * MiB;
constexpr size_t BAR_BYTES = 16384;
constexpr int MISC_OFF = 143424;
constexpr int NSLOT = 26;

typedef long long i64;
constexpr float FX = 16777216.0f, FXI = 1.0f / 16777216.0f;
__device__ __forceinline__ void fx_add(i64* p, float v) { atomicAdd((unsigned long long*)p, (unsigned long long)(i64)(v * FX)); }
__device__ __forceinline__ float fx_get(const i64* p) { return (float)(*p) * FXI; }

struct Args { const float* in[19]; float* out; unsigned char* ws; int ph_lo, ph_hi; };

__device__ __forceinline__ float silu_mul(float g, float u) { return g * __builtin_amdgcn_rcpf(1.0f + __builtin_amdgcn_exp2f(-g * LOG2E)) * u; }

struct EpiSwiGLU {
    static constexpr bool PERM = true; static constexpr int MID_T = -1;
    bf16_t* H; const LAS float* rsl;
    __device__ __forceinline__ void mid(f32x4 (&)[2][2][4][2], const Unit&, int, int) const {}
    __device__ __forceinline__ void operator()(const f32x4 (&acc)[2][2][4][2], const Unit& u, int wr, int wc, int fr, int fq, int ui) const {
        const int row0 = u.pm * 256 + wr * 64 + fr, hc = u.pn * 128 + wc * 32 + 8 * fq;
#pragma unroll
        for (int ai = 0; ai < 2; ++ai)
#pragma unroll
            for (int m = 0; m < 4; ++m) {
                const int r = row0 + ai * 128 + m * 16; const float rs = rsl[ui * 256 + wr * 64 + fr + ai * 128 + m * 16];
                const f32x4 g0 = acc[ai][0][m][0] * rs, g1 = acc[ai][0][m][1] * rs, u0 = acc[ai][1][m][0] * rs, u1 = acc[ai][1][m][1] * rs;
                u32x4 w;
                w.x = cvt_pk_bf16(silu_mul(g0[0], u0[0]), silu_mul(g0[1], u0[1])); w.y = cvt_pk_bf16(silu_mul(g0[2], u0[2]), silu_mul(g0[3], u0[3]));
                w.z = cvt_pk_bf16(silu_mul(g1[0], u1[0]), silu_mul(g1[1], u1[1])); w.w = cvt_pk_bf16(silu_mul(g1[2], u1[2]), silu_mul(g1[3], u1[3]));
                *(u32x4*)(H + (size_t)r * DFF + hc) = w;
            }
    }
};

struct EpiNull {
    static constexpr bool PERM = true; static constexpr int MID_T = -1;
    __device__ __forceinline__ void mid(f32x4 (&)[2][2][4][2], const Unit&, int, int) const {}
    __device__ __forceinline__ void operator()(const f32x4 (&acc)[2][2][4][2], const Unit& u, int wr, int wc, int fr, int fq, int ui) const {
#pragma unroll
        for (int ai = 0; ai < 2; ++ai)
#pragma unroll
            for (int bj = 0; bj < 2; ++bj)
#pragma unroll
                for (int m = 0; m < 4; ++m) { asm volatile("" :: "v"(acc[ai][bj][m][0]), "v"(acc[ai][bj][m][1])); }
    }
};

template <int MIDT> struct EpiResid {
    static constexpr bool PERM = true; static constexpr int MID_T = MIDT;
    const float* Xin; float* X; bf16_t* XB; i64* ssq_out; const i64* mid_ssq; float alpha;
    __device__ __forceinline__ void mid(f32x4 (&acc)[2][2][4][2], const Unit& u, int wr, int fr) const {
        const int row0 = u.pm * 256 + wr * 64 + fr;
        i64 q[2][4];
#pragma unroll
        for (int ai = 0; ai < 2; ++ai)
#pragma unroll
            for (int m = 0; m < 4; ++m) q[ai][m] = mid_ssq[row0 + ai * 128 + m * 16];
#pragma unroll
        for (int ai = 0; ai < 2; ++ai)
#pragma unroll
            for (int m = 0; m < 4; ++m) { const float rs = __builtin_amdgcn_rsqf((float)q[ai][m] * FXI * (1.0f / DH) + EPS);
#pragma unroll
                for (int bj = 0; bj < 2; ++bj) { acc[ai][bj][m][0] = acc[ai][bj][m][0] * rs; acc[ai][bj][m][1] = acc[ai][bj][m][1] * rs; } }
    }
    __device__ __forceinline__ void operator()(const f32x4 (&acc)[2][2][4][2], const Unit& u, int wr, int wc, int fr, int fq, int ui) const {
        const int row0 = u.pm * 256 + wr * 64 + fr, col0 = u.pn * 256 + wc * 32 + 8 * fq;
#pragma unroll
        for (int ai = 0; ai < 2; ++ai) {
            f32x4 xv[4][2][2];
#pragma unroll
            for (int m = 0; m < 4; ++m)
#pragma unroll
                for (int bj = 0; bj < 2; ++bj) { const float* xp = Xin + (size_t)(row0 + ai * 128 + m * 16) * DM + col0 + bj * 128; xv[m][bj][0] = *(const f32x4*)xp; xv[m][bj][1] = *(const f32x4*)(xp + 4); }
            __builtin_amdgcn_sched_barrier(0);
#pragma unroll
            for (int m = 0; m < 4; ++m) {
                const int r = row0 + ai * 128 + m * 16; float part = 0.f;
#pragma unroll
                for (int bj = 0; bj < 2; ++bj) {
                    float* xp = X + (size_t)r * DM + col0 + bj * 128;
                    const f32x4 x0 = xv[m][bj][0] + acc[ai][bj][m][0] * alpha, x1 = xv[m][bj][1] + acc[ai][bj][m][1] * alpha;
                    *(f32x4*)xp = x0; *(f32x4*)(xp + 4) = x1;
                    part += (x0[0] * x0[0] + x0[1] * x0[1]) + (x0[2] * x0[2] + x0[3] * x0[3]) + (x1[0] * x1[0] + x1[1] * x1[1]) + (x1[2] * x1[2] + x1[3] * x1[3]);
                    u32x4 w; w.x = cvt_pk_bf16(x0[0], x0[1]); w.y = cvt_pk_bf16(x0[2], x0[3]); w.z = cvt_pk_bf16(x1[0], x1[1]); w.w = cvt_pk_bf16(x1[2], x1[3]);
                    *(u32x4*)(XB + (size_t)r * DM + col0 + bj * 128) = w;
                }
                part += __shfl_xor(part, 16); part += __shfl_xor(part, 32);
                if (fq == 0) fx_add(ssq_out + r, part);
            }
            __builtin_amdgcn_sched_barrier(0);
        }
    }
};

struct EpiFinal {
    static constexpr bool PERM = true; static constexpr int MID_T = -1;
    const float* Xin; float* Out; i64* ssq; unsigned* cnt; const float* gain; float alpha;
    __device__ __forceinline__ void mid(f32x4 (&)[2][2][4][2], const Unit&, int, int) const {}
    __device__ __forceinline__ void operator()(f32x4 (&acc)[2][2][4][2], const Unit& u, int wr, int wc, int fr, int fq, int ui) const {
        const int row0 = u.pm * 256 + wr * 64 + fr, col0 = u.pn * 256 + wc * 32 + 8 * fq;
#pragma unroll
        for (int ai = 0; ai < 2; ++ai) {
            f32x4 xv[4][2][2];
#pragma unroll
            for (int m = 0; m < 4; ++m)
#pragma unroll
                for (int bj = 0; bj < 2; ++bj) { const float* xp = Xin + (size_t)(row0 + ai * 128 + m * 16) * DM + col0 + bj * 128; xv[m][bj][0] = *(const f32x4*)xp; xv[m][bj][1] = *(const f32x4*)(xp + 4); }
            __builtin_amdgcn_sched_barrier(0);
#pragma unroll
            for (int m = 0; m < 4; ++m) {
                float part = 0.f;
#pragma unroll
                for (int bj = 0; bj < 2; ++bj) {
                    const f32x4 x0 = xv[m][bj][0] + acc[ai][bj][m][0] * alpha, x1 = xv[m][bj][1] + acc[ai][bj][m][1] * alpha;
                    acc[ai][bj][m][0] = x0; acc[ai][bj][m][1] = x1;
                    part += (x0[0] * x0[0] + x0[1] * x0[1]) + (x0[2] * x0[2] + x0[3] * x0[3]) + (x1[0] * x1[0] + x1[1] * x1[1]) + (x1[2] * x1[2] + x1[3] * x1[3]);
                }
                part += __shfl_xor(part, 16); part += __shfl_xor(part, 32);
                if (fq == 0) fx_add(ssq + row0 + ai * 128 + m * 16, part);
            }
        }
        asm volatile("s_waitcnt vmcnt(0)" ::: "memory");
        unsigned* cw = cnt + 64 * u.pm;
        if ((threadIdx.x & 63) == 0) __hip_atomic_fetch_add(cw, 1u, __ATOMIC_RELAXED, __HIP_MEMORY_SCOPE_AGENT);
        { unsigned sp = 0;
          while ((unsigned)__builtin_amdgcn_readfirstlane(__hip_atomic_load(cw, __ATOMIC_RELAXED, __HIP_MEMORY_SCOPE_AGENT)) < 32u) { __builtin_amdgcn_s_sleep(2); if (++sp > (1u << 20)) break; } }
        f32x4 gv[2][2];
#pragma unroll
        for (int bj = 0; bj < 2; ++bj) { gv[bj][0] = *(const f32x4*)(gain + col0 + bj * 128); gv[bj][1] = *(const f32x4*)(gain + col0 + bj * 128 + 4); }
        i64 q[2][4];
#pragma unroll
        for (int ai = 0; ai < 2; ++ai)
#pragma unroll
            for (int m = 0; m < 4; ++m) q[ai][m] = (i64)__hip_atomic_load((unsigned long long*)(ssq + row0 + ai * 128 + m * 16), __ATOMIC_RELAXED, __HIP_MEMORY_SCOPE_AGENT);
#pragma unroll
        for (int ai = 0; ai < 2; ++ai)
#pragma unroll
            for (int m = 0; m < 4; ++m) {
                const float rs = __builtin_amdgcn_rsqf((float)q[ai][m] * FXI * (1.0f / DM) + EPS);
                float* op = Out + (size_t)(row0 + ai * 128 + m * 16) * DM + col0;
#pragma unroll
                for (int bj = 0; bj < 2; ++bj) { *(f32x4*)(op + bj * 128) = acc[ai][bj][m][0] * rs * gv[bj][0]; *(f32x4*)(op + bj * 128 + 4) = acc[ai][bj][m][1] * rs * gv[bj][1]; }
            }
    }
};

struct EpiQKU {
    static constexpr bool PERM = true; static constexpr int MID_T = -1;
    bf16_t *Q; const LAS float* rsl; const float* rcos; const float* rsin;
    __device__ __forceinline__ void mid(f32x4 (&)[2][2][4][2], const Unit&, int, int) const {}
    __device__ __forceinline__ void operator()(const f32x4 (&acc)[2][2][4][2], const Unit& u, int wr, int wc, int fr, int fq, int ui) const {
        const int sect = u.pn >> 1; bf16_t* base = Q + (size_t)sect * 8388608;
        const int row0 = u.pm * 256 + wr * 64 + fr, colt = (u.pn & 1) * 256 + wc * 32 + 8 * fq;
        const bool rot = (sect < 2) && ((wc & 1) == 0);
        const float sgn = (fq == 0) ? -1.f : 1.f; const float osc = (sect == 0) ? 0.125f * LOG2E : 1.f;
#pragma unroll
        for (int ai = 0; ai < 2; ++ai)
#pragma unroll
            for (int m = 0; m < 4; ++m) {
                const int r = row0 + ai * 128 + m * 16; const float rs = rsl[ui * 256 + wr * 64 + fr + ai * 128 + m * 16];
                const int pos = r & (SEQ - 1);
                f32x4 c0, c1, s0, s1;
                if (rot) { c0 = *(const f32x4*)(rcos + pos * 8); c1 = *(const f32x4*)(rcos + pos * 8 + 4); s0 = *(const f32x4*)(rsin + pos * 8); s1 = *(const f32x4*)(rsin + pos * 8 + 4); }
#pragma unroll
                for (int bj = 0; bj < 2; ++bj) {
                    f32x4 v0 = acc[ai][bj][m][0] * rs, v1 = acc[ai][bj][m][1] * rs;
                    if (sect == 2) { v0 = pg8::gelu4(v0); v1 = pg8::gelu4(v1); }
                    else {
                        if (rot) {
                            f32x4 p0, p1;
#pragma unroll
                            for (int i = 0; i < 4; ++i) { p0[i] = __shfl_xor(v0[i], 16); p1[i] = __shfl_xor(v1[i], 16); }
                            if (fq < 2) { v0 = v0 * c0 + p0 * s0 * sgn; v1 = v1 * c1 + p1 * s1 * sgn; }
                        }
                        v0 = v0 * osc; v1 = v1 * osc;
                    }
                    u32x4 w; w.x = cvt_pk_bf16(v0[0], v0[1]); w.y = cvt_pk_bf16(v0[2], v0[3]); w.z = cvt_pk_bf16(v1[0], v1[1]); w.w = cvt_pk_bf16(v1[2], v1[3]);
                    const int cc = colt + bj * 128;
                    if (sect == 2) *(u32x4*)(base + (size_t)r * DH + cc) = w;
                    else *(u32x4*)(base + ((size_t)((r >> 13) * 8 + (cc >> 6)) * SEQ + (r & (SEQ - 1))) * 64 + (cc & 63)) = w;
                }
            }
    }
};

struct EpiVG {
    static constexpr bool PERM = true; static constexpr int MID_T = -1;
    bf16_t *Vt1, *Vt4, *Vt16, *Gt; const LAS float* rsl; i64* lnsum; i64* lnsq;
    __device__ __forceinline__ void mid(f32x4 (&)[2][2][4][2], const Unit&, int, int) const {}
    __device__ __forceinline__ void operator()(const f32x4 (&acc)[2][2][4][2], const Unit& u, int wr, int wc, int fr, int fq, int ui) const {
        const int sect = u.pm >> 1;
        const int ch0 = (u.pm & 1) * 256 + wr * 64 + fr;
#pragma unroll
        for (int bj = 0; bj < 2; ++bj) {
            const int tok = u.pn * 256 + wc * 32 + 8 * fq + bj * 128;
            const LAS float* rp = rsl + ui * 256 + wc * 32 + 8 * fq + bj * 128;
            const f32x4 rs0 = *(const LAS f32x4*)rp, rs1 = *(const LAS f32x4*)(rp + 4);
            if (sect == 0) {
                const int b_ = tok >> 13, t0 = tok & (SEQ - 1);
#pragma unroll
                for (int ai = 0; ai < 2; ++ai)
#pragma unroll
                    for (int m = 0; m < 4; ++m) {
                        const int ch = ch0 + ai * 128 + m * 16;
                        const size_t bhb = (size_t)(b_ * 8 + (ch >> 6)) * (SEQ * 64) + (size_t)(ch & 63) * 8;
                        const f32x4 v0 = acc[ai][bj][m][0] * rs0, v1 = acc[ai][bj][m][1] * rs1;
                        u32x4 w; w.x = cvt_pk_bf16(v0[0], v0[1]); w.y = cvt_pk_bf16(v0[2], v0[3]); w.z = cvt_pk_bf16(v1[0], v1[1]); w.w = cvt_pk_bf16(v1[2], v1[3]);
                        *(u32x4*)(Vt1 + bhb + (size_t)(t0 >> 3) * 512) = w;
                        { const unsigned a0 = cvt_pk_bf16(v0[0], v1[0]), a1 = cvt_pk_bf16(v0[1], v1[1]), a2 = cvt_pk_bf16(v0[2], v1[2]), a3 = cvt_pk_bf16(v0[3], v1[3]);
                          const bool odd = fq & 1;
                          const unsigned s0 = odd ? a0 : a2, s1 = odd ? a1 : a3;
                          const unsigned r0 = (unsigned)__shfl_xor((int)s0, 16), r1 = (unsigned)__shfl_xor((int)s1, 16);
                          const int n = (t0 & ~15) >> 2, rb = odd ? 2 : 0;
                          bf16_t* p4 = Vt4 + bhb + (size_t)(rb * 256 + (n >> 3)) * 512 + (n & 7);
                          u32x2 q0, q1; q0.x = odd ? r0 : a0; q0.y = odd ? a2 : r0; q1.x = odd ? r1 : a1; q1.y = odd ? a3 : r1;
                          *(u32x2*)p4 = q0; *(u32x2*)(p4 + (size_t)256 * 512) = q1; }
                        { const bool hi = fq & 2;
                          const unsigned s0 = hi ? w.x : w.z, s1 = hi ? w.y : w.w;
                          const unsigned r0 = (unsigned)__shfl_xor((int)s0, 32), r1 = (unsigned)__shfl_xor((int)s1, 32);
                          const unsigned lo0 = hi ? r0 : w.x, lo1 = hi ? r1 : w.y, hi0 = hi ? w.z : r0, hi1 = hi ? w.w : r1;
                          const int n = (t0 & ~31) >> 4, rb = (t0 & 8) + (hi ? 4 : 0);
                          bf16_t* p16 = Vt16 + bhb + (size_t)(rb * 64 + (n >> 3)) * 512 + (n & 7);
                          *(unsigned*)(p16 + (size_t)0 * 64 * 512) = (lo0 & 0xffffu) | (hi0 << 16);
                          *(unsigned*)(p16 + (size_t)1 * 64 * 512) = (lo0 >> 16) | (hi0 & 0xffff0000u);
                          *(unsigned*)(p16 + (size_t)2 * 64 * 512) = (lo1 & 0xffffu) | (hi1 << 16);
                          *(unsigned*)(p16 + (size_t)3 * 64 * 512) = (lo1 >> 16) | (hi1 & 0xffff0000u); }
                    }
            } else {
                f32x4 sm0 = (f32x4){0.f, 0.f, 0.f, 0.f}, sm1 = sm0, sq0 = sm0, sq1 = sm0;
#pragma unroll
                for (int ai = 0; ai < 2; ++ai)
#pragma unroll
                    for (int m = 0; m < 4; ++m) {
                        const int ch = ch0 + ai * 128 + m * 16;
                        const f32x4 v0 = pg8::gelu4(acc[ai][bj][m][0] * rs0), v1 = pg8::gelu4(acc[ai][bj][m][1] * rs1);
                        sm0 = sm0 + v0; sm1 = sm1 + v1; sq0 = sq0 + v0 * v0; sq1 = sq1 + v1 * v1;
                        u32x4 w; w.x = cvt_pk_bf16(v0[0], v0[1]); w.y = cvt_pk_bf16(v0[2], v0[3]); w.z = cvt_pk_bf16(v1[0], v1[1]); w.w = cvt_pk_bf16(v1[2], v1[3]);
                        *(u32x4*)(Gt + ((size_t)(tok >> 3) * 512 + ch) * 8) = w;
                    }
#pragma unroll
                for (int i = 0; i < 4; ++i) {
                    float a0 = sm0[i], a1 = sm1[i], b0 = sq0[i], b1 = sq1[i];
#pragma unroll
                    for (int o = 1; o < 16; o <<= 1) { a0 += __shfl_xor(a0, o); a1 += __shfl_xor(a1, o); b0 += __shfl_xor(b0, o); b1 += __shfl_xor(b1, o); }
                    if (fr == 0) { fx_add(lnsum + tok + i, a0); fx_add(lnsum + tok + 4 + i, a1); fx_add(lnsq + tok + i, b0); fx_add(lnsq + tok + 4 + i, b1); }
                }
            }
        }
    }
};

__device__ __forceinline__ float wave_sum(float v) {
#pragma unroll
    for (int o = 1; o < 64; o <<= 1) v += __shfl_xor(v, o);
    return v;
}
__device__ __forceinline__ void transpose_item(const float* W, int Nsrc, int nsrc0, int k0, int K, bf16_t* WT, int drow0, const float* gain, LAS float* scr, int lane) {
    f32x4 v[16];
#pragma unroll
    for (int i = 0; i < 16; ++i) v[i] = __builtin_nontemporal_load((const f32x4*)(W + (size_t)(k0 + 4 * i + (lane >> 4)) * Nsrc + nsrc0 + 4 * (lane & 15)));
#pragma unroll
    for (int i = 0; i < 16; ++i) { const int kk = 4 * i + (lane >> 4); const float gsc = gain ? gain[kk] : 1.0f; LAS float* d = scr + kk * 65 + 4 * (lane & 15);
        d[0] = v[i][0] * gsc; d[1] = v[i][1] * gsc; d[2] = v[i][2] * gsc; d[3] = v[i][3] * gsc; }
    asm volatile("s_waitcnt lgkmcnt(0)" ::: "memory");
    const int c = lane & 7;
#pragma unroll
    for (int j = 0; j < 8; ++j) { const int n = (lane >> 3) + 8 * j; const LAS float* s = scr + (8 * c) * 65 + n;
        u32x4 o; o.x = cvt_pk_bf16(s[0 * 65], s[1 * 65]); o.y = cvt_pk_bf16(s[2 * 65], s[3 * 65]); o.z = cvt_pk_bf16(s[4 * 65], s[5 * 65]); o.w = cvt_pk_bf16(s[6 * 65], s[7 * 65]);
        *(u32x4*)(WT + (size_t)(drow0 + n) * K + k0 + 8 * c) = o; }
    asm volatile("s_waitcnt lgkmcnt(0)" ::: "memory");
}

constexpr int I_GU = 16 * (NGU / 64), I_D = (DFF / 64) * 16, I_INN = 16 * 24, I_INS = 16 * 16, I_OUT = 16 * 16;
constexpr int I_LAYER = 2 * I_GU + 2 * I_D + I_INN + I_INS + I_OUT;
__device__ __forceinline__ void convert_weights(const Args& a, LAS unsigned char* lds, int l, int it_lo, int it_hi, int w, int NW, int wave, int lane) {
    unsigned char* ws = as_global(a.ws);
    LAS float* scr = (LAS float*)(lds + wave * 16640);
    unsigned char* wl = ws + WS_W + (size_t)l * WL_STRIDE;
    for (int it = it_lo + w; it < it_hi; it += NW) {
        int r = it;
        if (r < 2 * I_GU) {
            const int f = r / I_GU; r %= I_GU;
            const int kb = r / (NGU / 64), nb = r % (NGU / 64), n0d = 64 * nb, hb = n0d >> 7;
            const float* src = (hb & 1) ? as_global(a.in[f ? 16 : 3]) : as_global(a.in[f ? 15 : 2]);
            transpose_item(src + (size_t)l * DM * DFF, DFF, (hb >> 1) * 128 + (n0d & 127), 64 * kb, DM, (bf16_t*)(wl + (f ? WL_GU2 : WL_GU1)), n0d, as_global(a.in[f ? 14 : 1]) + l * DM + 64 * kb, scr, lane);
            continue;
        }
        r -= 2 * I_GU;
        if (r < 2 * I_D) {
            const int f = r / I_D; r %= I_D;
            const int kb = r / 16, nb = r % 16;
            transpose_item(as_global(a.in[f ? 17 : 4]) + (size_t)l * DFF * DM, DM, 64 * nb, 64 * kb, DFF, (bf16_t*)(wl + (f ? WL_D2 : WL_D1)), 64 * nb, nullptr, scr, lane);
            continue;
        }
        r -= 2 * I_D;
        if (r < I_INN) {
            const int kb = r / 24, nb = r % 24, n0d = 64 * nb;
            transpose_item(as_global(a.in[6]) + (size_t)l * DM * 2560, 2560, n0d < 1024 ? n0d : n0d + 512, 64 * kb, DM, (bf16_t*)(wl + WL_INN), n0d, as_global(a.in[5]) + l * DM + 64 * kb, scr, lane);
            continue;
        }
        r -= I_INN;
        if (r < I_INS) {
            const int kb = r / 16, nb = r % 16, n0d = 64 * nb;
            transpose_item(as_global(a.in[6]) + (size_t)l * DM * 2560, 2560, n0d < 512 ? 1024 + n0d : 1536 + n0d, 64 * kb, DM, (bf16_t*)(wl + WL_INS), n0d, as_global(a.in[5]) + l * DM + 64 * kb, scr, lane);
            continue;
        }
        r -= I_INS;
        {
            const int kb = r / 16, nb = r % 16, k0 = 64 * kb;
            const float* gain = k0 < 512 ? as_global(a.in[11]) + l * DH + k0 : as_global(a.in[12]) + l * DH + (k0 - 512);
            transpose_item(as_global(a.in[13]) + (size_t)l * DM * DM, DM, 64 * nb, k0, DM, (bf16_t*)(wl + WL_OUT), 64 * nb, gain, scr, lane);
        }
    }
}

__device__ __forceinline__ void prologue(const Args& a, LAS unsigned char* lds, int gw, int NGW, int wave, int lane, int nlayers) {
    unsigned char* ws = as_global(a.ws);
    float* outp = as_global(a.out);
#pragma unroll 1
    for (int l = 0; l < nlayers; ++l) convert_weights(a, lds, l, 0, I_LAYER, gw, NGW, wave, lane);
    i64* stats = (i64*)(ws + WS_STATS);
    for (int m = gw; m < MTOK; m += NGW) {
        const f32x4* xr = (const f32x4*)(as_global(a.in[0]) + (size_t)m * DM) + lane;
        u32x2* xb = (u32x2*)((bf16_t*)(ws + WS_XB) + (size_t)m * DM) + lane;
        float s = 0.f; f32x4 xin[4];
#pragma unroll
        for (int j = 0; j < 4; ++j) xin[j] = xr[64 * j];
#pragma unroll
        for (int j = 0; j < 4; ++j) { const f32x4 v = xin[j]; s += (v[0] * v[0] + v[1] * v[1]) + (v[2] * v[2] + v[3] * v[3]);
            u32x2 w; w.x = cvt_pk_bf16(v[0], v[1]); w.y = cvt_pk_bf16(v[2], v[3]); xb[64 * j] = w; }
        s = wave_sum(s);
        if (lane == 0) stats[m] = (i64)(s * FX);
    }
    { const int gt = gw * 64 + lane, NGT = NGW * 64;
      for (int i = gt; i < (NSLOT - 1) * MTOK / 2; i += NGT) ((f32x4*)(stats + MTOK))[i] = (f32x4){0.f, 0.f, 0.f, 0.f};
      float* rc = (float*)(ws + WS_ROT); float* rsn = rc + SEQ * 8;
      for (int i = gt; i < SEQ * 8; i += NGT) { const int pos = i >> 3, j = i & 7;
          const float inv = exp2f(-(float)j * 2.36644607116552f);
          const float ang = (float)pos * inv;
          const double rev = (double)ang * 0.15915494309189535; const float fr_ = (float)(rev - floor(rev));
          rc[i] = __builtin_amdgcn_cosf(fr_); rsn[i] = __builtin_amdgcn_sinf(fr_); }
      bf16_t* sw = (bf16_t*)(ws + WS_SGUW);
      for (int i = gt; i < DEPTH * 4 * 128 * 128 / 4; i += NGT) { const f32x4 v = ((const f32x4*)as_global(a.in[9]))[i]; u32x2 w; w.x = cvt_pk_bf16(v[0], v[1]); w.y = cvt_pk_bf16(v[2], v[3]); ((u32x2*)sw)[i] = w; }
    }
}

constexpr int OP = 68;
constexpr int ABLK = 512;
__device__ __forceinline__ void attn_unit(LAS unsigned char* lds, int b, int h, int blk, const bf16_t* Q, const bf16_t* Kb, const bf16_t* Vt1, const bf16_t* Vt4, const bf16_t* Vt16,
                                          bf16_t* MIX, i64* ssq_a, int wid, int lane_in) {
    int lane = lane_in; asm volatile("" : "+v"(lane));
    LAS float* Oacc = (LAS float*)lds; LAS float* Ml = Oacc + ABLK * OP;
    const int qi = lane & 15, kq = lane >> 4, T0 = blk * ABLK;
    const size_t tb = (size_t)b * SEQ; const size_t bhb = (size_t)(b * 8 + h) * (SEQ * 64);
#pragma unroll 1
    for (int p = 0; p < 3; ++p) {
        const int lg = 2 * p, L = SEQ >> lg;
        const bf16_t* Vt = p == 0 ? Vt1 : (p == 1 ? Vt4 : Vt16);
#pragma unroll 1
        for (int it = 0; it < 2; ++it) {
            const int pi = wid * 2 + it;
            int r, n0;
            if (p == 0) { r = 0; n0 = T0 + 32 * pi; } else if (p == 1) { r = pi >> 2; n0 = (T0 >> 2) + 32 * (pi & 3); } else { r = pi; n0 = T0 >> 4; }
            const int ws_ = n0 - 64;
            int qtok[2]; bf16x8 qf[2][2];
#pragma unroll
            for (int g = 0; g < 2; ++g) { qtok[g] = ((n0 + 16 * g + qi) << lg) + r; const bf16_t* qp = Q + bhb + (size_t)qtok[g] * 64 + kq * 16; qf[g][0] = *(const bf16x8*)qp; qf[g][1] = *(const bf16x8*)(qp + 8); }
            bf16x8 kf[10][2];
#pragma unroll
            for (int t = 0; t < 10; ++t) {
                const int widx = 32 * (t >> 1) + 8 * (qi >> 2) + 4 * (t & 1) + (qi & 3);
                int kn = ws_ + widx; kn = kn < 0 ? 0 : (kn > L - 1 ? L - 1 : kn);
                const bf16_t* kp = Kb + bhb + (size_t)((kn << lg) + r) * 64 + kq * 16;
                kf[t][0] = *(const bf16x8*)kp; kf[t][1] = *(const bf16x8*)(kp + 8);
            }
            __builtin_amdgcn_sched_barrier(0);
            f32x4 s[2][10];
            __builtin_amdgcn_s_setprio(1);
#pragma unroll
            for (int t = 0; t < 10; ++t)
#pragma unroll
                for (int g = 0; g < 2; ++g) {
                    f32x4 z = (f32x4){0.f, 0.f, 0.f, 0.f};
                    z = __builtin_amdgcn_mfma_f32_16x16x32_bf16(kf[t][0], qf[g][0], z, 0, 0, 0);
                    z = __builtin_amdgcn_mfma_f32_16x16x32_bf16(kf[t][1], qf[g][1], z, 0, 0, 0);
                    s[g][t] = z;
                }
            __builtin_amdgcn_s_setprio(0);
            __builtin_amdgcn_sched_barrier(0);
            bf16x8 vf[5][4];
#pragma unroll
            for (int c = 0; c < 5; ++c) {
                int gk = ws_ + 32 * c + 8 * kq; gk = (gk < 0 || gk >= L) ? 0 : gk;
                const bf16_t* vp = Vt + bhb + ((size_t)(r * (L >> 3) + (gk >> 3)) * 64 + qi) * 8;
#pragma unroll
                for (int dt = 0; dt < 4; ++dt) vf[c][dt] = *(const bf16x8*)(vp + dt * 128);
            }
            __builtin_amdgcn_sched_barrier(0);
            float mx[2], lsum[2];
#pragma unroll
            for (int g = 0; g < 2; ++g) {
                float m_ = -1e30f;
                int lo = 16 * g + qi, hi = 128 + 16 * g + qi; lo = lo > -ws_ ? lo : -ws_; hi = hi < L - 1 - ws_ ? hi : L - 1 - ws_;
                const int lo8 = lo - 8 * kq; const unsigned span = (unsigned)(hi - lo);
#pragma unroll
                for (int t = 0; t < 10; ++t)
#pragma unroll
                    for (int i = 0; i < 4; ++i) {
                        const int c = 32 * (t >> 1) + 4 * (t & 1) + i;
                        const bool ok = (unsigned)(c - lo8) <= span;
                        const float v = ok ? s[g][t][i] : -1e30f; s[g][t][i] = v; m_ = fmaxf(m_, v);
                    }
                m_ = fmaxf(m_, __shfl_xor(m_, 16)); m_ = fmaxf(m_, __shfl_xor(m_, 32));
                float l_ = 0.f;
#pragma unroll
                for (int t = 0; t < 10; ++t)
#pragma unroll
                    for (int i = 0; i < 4; ++i) { const float pv = __builtin_amdgcn_exp2f(s[g][t][i] - m_); s[g][t][i] = pv; l_ += pv; }
                l_ += __shfl_xor(l_, 16); l_ += __shfl_xor(l_, 32);
                mx[g] = m_; lsum[g] = l_;
            }
            f32x4 o[2][4];
#pragma unroll
            for (int g = 0; g < 2; ++g)
#pragma unroll
                for (int dt = 0; dt < 4; ++dt) o[g][dt] = (f32x4){0.f, 0.f, 0.f, 0.f};
#pragma unroll
            for (int c = 0; c < 5; ++c)
#pragma unroll
                for (int g = 0; g < 2; ++g) {
                    union { u32x4 u; bf16x8 v; } pf;
                    pf.u.x = cvt_pk_bf16(s[g][2 * c][0], s[g][2 * c][1]); pf.u.y = cvt_pk_bf16(s[g][2 * c][2], s[g][2 * c][3]);
                    pf.u.z = cvt_pk_bf16(s[g][2 * c + 1][0], s[g][2 * c + 1][1]); pf.u.w = cvt_pk_bf16(s[g][2 * c + 1][2], s[g][2 * c + 1][3]);
#pragma unroll
                    for (int dt = 0; dt < 4; ++dt) o[g][dt] = __builtin_amdgcn_mfma_f32_16x16x32_bf16(vf[c][dt], pf.v, o[g][dt], 0, 0, 0);
                }
#pragma unroll
            for (int g = 0; g < 2; ++g) {
                const int tl = qtok[g] - T0;
                LAS float* orow = Oacc + tl * OP + 4 * kq;
                if (p == 0) {
#pragma unroll
                    for (int dt = 0; dt < 4; ++dt) *(LAS f32x4*)(orow + 16 * dt) = o[g][dt];
                    if (kq == 0) { Ml[2 * tl] = mx[g]; Ml[2 * tl + 1] = lsum[g]; }
                } else {
                    const float mo = Ml[2 * tl], lo = Ml[2 * tl + 1];
                    const float mn = fmaxf(mo, mx[g]), fa = __builtin_amdgcn_exp2f(mo - mn), fb = __builtin_amdgcn_exp2f(mx[g] - mn);
                    f32x4 om[4];
#pragma unroll
                    for (int dt = 0; dt < 4; ++dt) om[dt] = *(const LAS f32x4*)(orow + 16 * dt) * fa + o[g][dt] * fb;
                    const float ln = lo * fa + lsum[g] * fb;
                    asm volatile("s_waitcnt lgkmcnt(0)" ::: "memory");
#pragma unroll
                    for (int dt = 0; dt < 4; ++dt) *(LAS f32x4*)(orow + 16 * dt) = om[dt];
                    if (kq == 0) { Ml[2 * tl] = mn; Ml[2 * tl + 1] = ln; }
                }
            }
        }
        __syncthreads();
    }
#pragma unroll 1
    for (int ps = 0; ps < ABLK / 256; ++ps) {
      const int tid = wid * 64 + lane, tl = ps * 256 + (tid >> 1), half = tid & 1;
      const float inv = 1.0f / Ml[2 * tl + 1]; const LAS float* orow = Oacc + tl * OP + 32 * half; float part = 0.f;
      bf16_t* op = MIX + (tb + T0 + tl) * DM + h * 64 + 32 * half;
#pragma unroll
      for (int j = 0; j < 4; ++j) { const f32x4 va = *(const LAS f32x4*)(orow + 8 * j) * inv, vb = *(const LAS f32x4*)(orow + 8 * j + 4) * inv;
          part += (va[0] * va[0] + va[1] * va[1]) + (va[2] * va[2] + va[3] * va[3]) + (vb[0] * vb[0] + vb[1] * vb[1]) + (vb[2] * vb[2] + vb[3] * vb[3]);
          u32x4 w; w.x = cvt_pk_bf16(va[0], va[1]); w.y = cvt_pk_bf16(va[2], va[3]); w.z = cvt_pk_bf16(vb[0], vb[1]); w.w = cvt_pk_bf16(vb[2], vb[3]); *(u32x4*)(op + 8 * j) = w; }
      part += __shfl_xor(part, 1);
      if (half == 0) fx_add(ssq_a + tb + T0 + tl, part);
    }
    __syncthreads();
}

constexpr int SGU_TAB = 131072;
__device__ __forceinline__ void sgu_unit(LAS unsigned char* lds, int tok0, const bf16_t* Gt, const bf16_t* U, const bf16_t* Wb, const float* bs, const float* lng, const float* lnb,
                                         const i64* lnsum, const i64* lnsq, bf16_t* MIX, int wid, int lane_in) {
    int lane = lane_in; asm volatile("" : "+v"(lane));
    LAS float* MU = (LAS float*)(lds + SGU_TAB); LAS float* RS = MU + 128; LAS float* SS = RS + 128;
    const int tid = wid * 64 + lane;
#pragma unroll
    for (int i = 0; i < 16; ++i) { const int P = ((i * 8 + wid) << 6) + lane, row = P >> 4, piece = (P & 15) ^ (row & 15);
        __builtin_amdgcn_global_load_lds((const unsigned*)(Wb + (size_t)row * 128 + piece * 8), (LAS unsigned*)(lds + (i * 8 + wid) * 1024), 16, 0, 0); }
    const int g = wid >> 1, e0 = 64 * (wid & 1), li = lane & 15, kq = lane >> 4;
    float gg[4], gb[4]; u32x4 rawg[4][4];
#pragma unroll
    for (int et = 0; et < 4; ++et) { const int ch = g * 128 + e0 + 16 * (li >> 2) + 4 * et + (li & 3);
        gg[et] = lng[ch]; gb[et] = lnb[ch];
#pragma unroll
        for (int c = 0; c < 4; ++c) rawg[c][et] = *(const u32x4*)(Gt + ((size_t)((tok0 + 32 * c + 8 * kq) >> 3) * 512 + ch) * 8); }
    if (tid < 128) { const float sm = fx_get(lnsum + tok0 + tid) * (1.0f / DH); const float var = fx_get(lnsq + tok0 + tid) * (1.0f / DH) - sm * sm;
        MU[tid] = sm; RS[tid] = __builtin_amdgcn_rsqf(fmaxf(var, 0.f) + EPS); }
    asm volatile("s_waitcnt vmcnt(0)" ::: "memory");
    __syncthreads();
    f32x4 acc[4][8];
#pragma unroll
    for (int et = 0; et < 4; ++et)
#pragma unroll
        for (int tt = 0; tt < 8; ++tt) acc[et][tt] = (f32x4){0.f, 0.f, 0.f, 0.f};
    const LAS unsigned char* wrow = lds + (size_t)(g * 128 + li) * 256;
#pragma unroll
    for (int c = 0; c < 4; ++c) {
        const int s0 = 32 * c + 8 * kq;
        const f32x4 mu0 = *(const LAS f32x4*)(MU + s0), mu1 = *(const LAS f32x4*)(MU + s0 + 4), rs0 = *(const LAS f32x4*)(RS + s0), rs1 = *(const LAS f32x4*)(RS + s0 + 4);
        bf16x8 af[4];
#pragma unroll
        for (int et = 0; et < 4; ++et) {
            const u32x4 raw = rawg[c][et];
            f32x4 x0, x1;
            x0[0] = __uint_as_float(raw.x << 16); x0[1] = __uint_as_float(raw.x & 0xffff0000u); x0[2] = __uint_as_float(raw.y << 16); x0[3] = __uint_as_float(raw.y & 0xffff0000u);
            x1[0] = __uint_as_float(raw.z << 16); x1[1] = __uint_as_float(raw.z & 0xffff0000u); x1[2] = __uint_as_float(raw.w << 16); x1[3] = __uint_as_float(raw.w & 0xffff0000u);
            x0 = (x0 - mu0) * rs0 * gg[et] + gb[et]; x1 = (x1 - mu1) * rs1 * gg[et] + gb[et];
            union { u32x4 u; bf16x8 v; } pk;
            pk.u.x = cvt_pk_bf16(x0[0], x0[1]); pk.u.y = cvt_pk_bf16(x0[2], x0[3]); pk.u.z = cvt_pk_bf16(x1[0], x1[1]); pk.u.w = cvt_pk_bf16(x1[2], x1[3]);
            af[et] = pk.v;
        }
#pragma unroll
        for (int tt = 0; tt < 8; ++tt) {
            const bf16x8 wf = *(const LAS bf16x8*)(wrow + tt * 4096 + (((4 * c + kq) ^ li) << 4));
#pragma unroll
            for (int et = 0; et < 4; ++et) acc[et][tt] = __builtin_amdgcn_mfma_f32_16x16x32_bf16(af[et], wf, acc[et][tt], 0, 0, 0);
        }
    }
    u32x4 uraw[8][2]; float biasv[8];
#pragma unroll
    for (int tt = 0; tt < 8; ++tt) { biasv[tt] = bs[g * 128 + 16 * tt + li];
        const bf16_t* up = U + (size_t)(tok0 + 16 * tt + li) * DH + g * 128 + e0 + 16 * kq;
        uraw[tt][0] = *(const u32x4*)up; uraw[tt][1] = *(const u32x4*)(up + 8); }
    __builtin_amdgcn_sched_barrier(0);
#pragma unroll
    for (int tt = 0; tt < 8; ++tt) {
        const int t = 16 * tt + li; const float bias = biasv[tt]; float part = 0.f;
#pragma unroll
        for (int et = 0; et < 4; ++et) {
            const unsigned r0 = (et & 1) ? uraw[tt][et >> 1].z : uraw[tt][et >> 1].x, r1 = (et & 1) ? uraw[tt][et >> 1].w : uraw[tt][et >> 1].y;
            f32x4 uv; uv[0] = __uint_as_float(r0 << 16); uv[1] = __uint_as_float(r0 & 0xffff0000u); uv[2] = __uint_as_float(r1 << 16); uv[3] = __uint_as_float(r1 & 0xffff0000u);
            const f32x4 v = uv * (acc[et][tt] + bias); acc[et][tt] = v;
            part += (v[0] * v[0] + v[1] * v[1]) + (v[2] * v[2] + v[3] * v[3]);
        }
        part += __shfl_xor(part, 16); part += __shfl_xor(part, 32);
        if (kq == 0) SS[wid * 128 + t] = part;
    }
    __syncthreads();
#pragma unroll
    for (int tt = 0; tt < 8; ++tt) {
        const int t = 16 * tt + li; float tot = 0.f;
#pragma unroll
        for (int w8 = 0; w8 < 8; ++w8) tot += SS[w8 * 128 + t];
        const float rstd = __builtin_amdgcn_rsqf(tot * (1.0f / DH) + EPS);
        bf16_t* mp = MIX + (size_t)(tok0 + t) * DM + DH + g * 128 + e0 + 16 * kq;
#pragma unroll
        for (int eh = 0; eh < 2; ++eh) { const f32x4 va = acc[2 * eh][tt] * rstd, vb = acc[2 * eh + 1][tt] * rstd;
            u32x4 w; w.x = cvt_pk_bf16(va[0], va[1]); w.y = cvt_pk_bf16(va[2], va[3]); w.z = cvt_pk_bf16(vb[0], vb[1]); w.w = cvt_pk_bf16(vb[2], vb[3]); *(u32x4*)(mp + 8 * eh) = w; }
    }
    __syncthreads();
}

#define XB_TMO      128
#define XB_XCNT(j)  (256  + 64 * (j))
#define XB_XSUB(j)  (1280 + 64 * (j))
#define XB_XGEN(j)  (2304 + 64 * (j))
#define XB_TOP      3328
#define XB_TOPGEN   3392
#define XCD_BAR_WORDS 3456
#define XB_SPIN_CAP (1u << 18)

__device__ __forceinline__ unsigned xb_ld(unsigned* p)              { return __hip_atomic_load(p, __ATOMIC_RELAXED, __HIP_MEMORY_SCOPE_AGENT); }
__device__ __forceinline__ unsigned xb_add(unsigned* p, unsigned v) { return __hip_atomic_fetch_add(p, v, __ATOMIC_RELAXED, __HIP_MEMORY_SCOPE_AGENT); }
__device__ __forceinline__ unsigned xb_xcc_id() { return (unsigned)__builtin_amdgcn_s_getreg((3 << 11) | 20) & 0xFu; }
#define XB_SPIN(cond, bar) do { unsigned _sp = 0; while (cond) { __builtin_amdgcn_s_sleep(1); \
    if ((++_sp & 255u) == 0u) { if (xb_ld(&(bar)[XB_TMO])) break; if (_sp > XB_SPIN_CAP) { atomicAdd(&(bar)[XB_TMO], 1u); break; } } } } while (0)

struct XcdBarrier {
    unsigned* bar; unsigned x;
    volatile LAS unsigned* st;
};

__device__ __forceinline__ XcdBarrier xcd_barrier_post(unsigned* bar, volatile LAS unsigned* st) {
    XcdBarrier b; b.bar = bar; b.x = xb_xcc_id(); b.st = st;
    if (threadIdx.x == 0) (void)xb_add(&bar[XB_XCNT(b.x)], 1u);
    return b;
}
__device__ __forceinline__ void xcd_barrier_complete(unsigned* bar, unsigned x, unsigned& nloc, unsigned& nx) {
    const unsigned G = gridDim.x * gridDim.y * gridDim.z;
    unsigned sum, cnt, mine, sp = 0u;
    for (;;) {
        sum = 0u; cnt = 0u; mine = 0u;
#pragma unroll
        for (unsigned j = 0; j < 16; ++j) { const unsigned c = xb_ld(&bar[XB_XCNT(j)]); sum += c; cnt += (c > 0u) ? 1u : 0u; mine = (j == x) ? c : mine; }
        if (sum == G) break;
        __builtin_amdgcn_s_sleep(1);
        if ((++sp & 255u) == 0u) { if (xb_ld(&bar[XB_TMO])) break; if (sp > XB_SPIN_CAP) { atomicAdd(&bar[XB_TMO], 1u); break; } }
    }
    nloc = mine > 0u ? mine : 1u; nx = cnt > 0u ? cnt : 1u;
}

__device__ __forceinline__ void xcd_barrier(const XcdBarrier& b) {
    asm volatile("s_waitcnt vmcnt(0)" ::: "memory");
    __syncthreads();
    if (threadIdx.x == 0) {
        unsigned* bar = b.bar;
        __builtin_amdgcn_s_waitcnt(0);
        unsigned nloc = b.st[0], nx = b.st[1];
        if (nloc == 0u) { xcd_barrier_complete(bar, b.x, nloc, nx); b.st[0] = nloc; b.st[1] = nx; }
        const unsigned old = xb_add(&bar[XB_XSUB(b.x)], 1u);
        const unsigned gen = old / nloc;
        if (old + 1u == (gen + 1u) * nloc) {
            __builtin_amdgcn_fence(__ATOMIC_RELEASE, "agent");
            asm volatile("s_waitcnt vmcnt(0)" ::: "memory");
            const unsigned og = xb_add(&bar[XB_TOP], 1u);
            const unsigned tg = og / nx;
            if (og + 1u == (tg + 1u) * nx) xb_add(&bar[XB_TOPGEN], 1u);
            else XB_SPIN(xb_ld(&bar[XB_TOPGEN]) == tg, bar);
            __builtin_amdgcn_fence(__ATOMIC_ACQUIRE, "agent");
            xb_add(&bar[XB_XGEN(b.x)], 1u);
            asm volatile("s_waitcnt vmcnt(0)" ::: "memory");
        } else {
            XB_SPIN(xb_ld(&bar[XB_XGEN(b.x)]) == gen, bar);
            __builtin_amdgcn_fence(__ATOMIC_ACQUIRE, "agent");
            asm volatile("s_waitcnt vmcnt(0)" ::: "memory");
        }
    }
    __syncthreads();
}

constexpr int RSL_OFF = 131072, RSL_UNITS = 6;
template <bool BY_COL> __device__ __forceinline__ void stage_rstd(LAS unsigned char* lds, const pg8::StaticOrder& S, const i64* ssq) {
    LAS float* rsl = (LAS float*)(lds + RSL_OFF); const int tid = threadIdx.x;
#pragma unroll 1
    for (int i = 0; i < RSL_UNITS; ++i) { Unit u; if (!S.next(i, u)) break;
        if (tid < 256) rsl[i * 256 + tid] = __builtin_amdgcn_rsqf(fx_get(ssq + (BY_COL ? u.pn : u.pm) * 256 + tid) * (1.0f / DM) + EPS); }
    __syncthreads();
}

constexpr int PH_PER_LAYER = 7, N_PHASES = 1 + DEPTH * PH_PER_LAYER + 1;

__global__ void __launch_bounds__(NWAVES * 64, 2) fwd_kernel(Args a) {
    extern __shared__ __attribute__((aligned(16))) unsigned char lds_raw[];
    LAS unsigned char* lds = (LAS unsigned char*)lds_raw;
    const int G = gridDim.x, cu = blockIdx.x;
    const int lo = a.ph_lo, hi = a.ph_hi;
    const bool spread = (G == 256) && MK_ONE;
#define IDLE_CONVERT(slot) do { if (spread && l + 1 < DEPTH && cu >= 128) { __builtin_amdgcn_sched_barrier(0); int tid_ = threadIdx.x; asm volatile("" : "+v"(tid_) :: "memory"); const int wave_ = __builtin_amdgcn_readfirstlane(tid_ >> 6); \
        convert_weights(a, lds, l + 1, (slot) * (I_LAYER / 3), (slot) == 2 ? I_LAYER : ((slot) + 1) * (I_LAYER / 3), (cu - 128) * NWAVES + wave_, 128 * NWAVES, wave_, tid_ & 63); __syncthreads(); } } while (0)
#if MK_ONE
    cg::grid_group grid = cg::this_grid();
    { volatile LAS unsigned* misc = (volatile LAS unsigned*)(lds + MISC_OFF); if (threadIdx.x < 32) misc[threadIdx.x] = 0u; __syncthreads(); }
    XcdBarrier bar; bar.bar = (unsigned*)(as_global(a.ws) + WS_BAR); bar.x = xb_xcc_id(); bar.st = (volatile LAS unsigned*)(lds + MISC_OFF) + 8;
#define SEAM(k) do { if ((k) + 1 < hi) { if ((k) == 0) grid.sync(); else { xcd_barrier(bar); if (DUP & 4) xcd_barrier(bar); } } } while (0)
#else
#define SEAM(k) do { } while (0)
#endif
#define IN(k) (lo <= (k) && (k) < hi)
#define WSBASE() GAS unsigned char* wsg_ = (GAS unsigned char*)a.ws; asm volatile("" : "+s"(wsg_)); unsigned char* ws = (unsigned char*)wsg_; i64* stats = (i64*)(ws + WS_STATS); i64* st = stats + (size_t)(6 * l) * MTOK; unsigned char* wl = ws + WS_W + (size_t)l * WL_STRIDE; (void)st; (void)wl

    if (!(SKIP & 32) && IN(0)) {
        const int tid = threadIdx.x, lane = tid & 63, wave = __builtin_amdgcn_readfirstlane(tid >> 6);
        prologue(a, lds, cu * NWAVES + wave, G * NWAVES, wave, lane, spread ? 1 : DEPTH); __syncthreads();
        if (DUP & 8) { prologue(a, lds, cu * NWAVES + wave, G * NWAVES, wave, lane, spread ? 1 : DEPTH); __syncthreads(); }
#if MK_ONE
        if (cu == 0) { unsigned* bw = (unsigned*)(as_global(a.ws) + WS_BAR); for (int i = tid; i < (int)(BAR_BYTES / 4); i += NWAVES * 64) bw[i] = 0u; }
        grid.sync();
        if (tid == 0) (void)xb_add(&bar.bar[XB_XCNT(bar.x)], 1u);
#endif
    }

#pragma unroll 1
    for (int l = 0; l < DEPTH; ++l) {
        const int pb = 1 + l * PH_PER_LAYER;
#pragma unroll 1
        for (int f = 0; f < 2; ++f) {
            const int p0 = pb + (f ? 5 : 0);
            if (!(SKIP & 1) && IN(p0)) {
                WSBASE();
                pg8::Gemm g{(const bf16_t*)(ws + WS_XB), (const bf16_t*)(wl + (f ? WL_GU2 : WL_GU1)), MTOK, NGU, DM}; pg8::StaticOrder S; S.init(MTOK, NGU, G, cu);
                stage_rstd<false>(lds, S, st + (f ? 5 : 0) * MTOK);
                EpiSwiGLU E{(bf16_t*)(ws + WS_H), (const LAS float*)(lds + RSL_OFF)};
                pg8::gemm_phase<EpiSwiGLU, pg8::StaticOrder, true>(lds, g, S, E);
                if (DUP & 32) pg8::gemm_phase<EpiSwiGLU, pg8::StaticOrder, true>(lds, g, S, E);
                if (DUP & 256) { EpiNull EN; pg8::gemm_phase<EpiNull, pg8::StaticOrder, true>(lds, g, S, EN); }
                IDLE_CONVERT(f ? 2 : 0);
                SEAM(p0);
            }
            if (!(SKIP & 64) && IN(p0 + 1)) {
                WSBASE();
                pg8::Gemm g{(const bf16_t*)(ws + WS_H), (const bf16_t*)(wl + (f ? WL_D2 : WL_D1)), MTOK, DM, DFF}; pg8::StaticOrder S; S.init(MTOK, DM, G, cu);
                if (FUSE_FINAL && l == DEPTH - 1 && f == 1 && G == 256) {
                    EpiFinal E{as_global(a.out), as_global(a.out), st + 6 * MTOK, (unsigned*)(stats + (size_t)25 * MTOK), as_global(a.in[18]), 0.5f};
                    pg8::gemm_phase<EpiFinal, pg8::StaticOrder, true>(lds, g, S, E);
                } else {
                    EpiResid<-1> E{(l == 0 && f == 0) ? as_global(a.in[0]) : (const float*)as_global(a.out), as_global(a.out), (bf16_t*)(ws + WS_XB), st + (f ? 6 : 1) * MTOK, nullptr, 0.5f};
                    pg8::gemm_phase<EpiResid<-1>, pg8::StaticOrder, true>(lds, g, S, E);
                    SEAM(p0 + 1);
                }
            }
            if (f == 1) break;
            if (!(SKIP & 2) && IN(pb + 2)) {
                { WSBASE();
                  pg8::Gemm g{(const bf16_t*)(ws + WS_XB), (const bf16_t*)(wl + WL_INN), MTOK, 1536, DM}; pg8::StaticOrder S; S.init(MTOK, 1536, G, cu);
                  stage_rstd<false>(lds, S, st + 1 * MTOK);
                  EpiQKU E{(bf16_t*)(ws + WS_Q), (const LAS float*)(lds + RSL_OFF), (const float*)(ws + WS_ROT), (const float*)(ws + WS_ROT) + SEQ * 8};
                  pg8::gemm_phase<EpiQKU, pg8::StaticOrder, true>(lds, g, S, E);
                  if (DUP & 16) pg8::gemm_phase<EpiQKU, pg8::StaticOrder, true>(lds, g, S, E); }
                { WSBASE();
                  pg8::Gemm g{(const bf16_t*)(wl + WL_INS), (const bf16_t*)(ws + WS_XB), 1024, MTOK, DM}; pg8::StaticOrder S; S.init(1024, MTOK, G, G - 1 - cu);
                  stage_rstd<true>(lds, S, st + 1 * MTOK);
                  EpiVG E{(bf16_t*)(ws + WS_VT1), (bf16_t*)(ws + WS_VT4), (bf16_t*)(ws + WS_VT16), (bf16_t*)(ws + WS_GT), (const LAS float*)(lds + RSL_OFF), st + 3 * MTOK, st + 4 * MTOK};
                  pg8::gemm_phase<EpiVG, pg8::StaticOrder, true>(lds, g, S, E);
                  if (DUP & 16) { EpiVG E2 = E; E2.lnsum = stats + (size_t)30 * MTOK; E2.lnsq = stats + (size_t)31 * MTOK; pg8::gemm_phase<EpiVG, pg8::StaticOrder, true>(lds, g, S, E2); } }
                IDLE_CONVERT(1);
                SEAM(pb + 2);
            }
            if (IN(pb + 3)) {
                const int tid = threadIdx.x, lane = tid & 63, wave = __builtin_amdgcn_readfirstlane(tid >> 6);
                if (!(SKIP & 8)) { WSBASE();
                  for (int u = cu; u < MTOK / 128; u += G) for (int rp = 0; rp < ((DUP & 2) ? 2 : 1); ++rp)
                    sgu_unit(lds, u * 128, (const bf16_t*)(ws + WS_GT), (const bf16_t*)(ws + WS_U), (const bf16_t*)(ws + WS_SGUW) + (size_t)l * 4 * 16384, as_global(a.in[10]) + l * 512, as_global(a.in[7]) + l * DH, as_global(a.in[8]) + l * DH,
                             st + 3 * MTOK, st + 4 * MTOK, (bf16_t*)(ws + WS_MIX), wave, lane); }
                if (!(SKIP & 4)) { WSBASE();
                  for (int u = cu; u < 256; u += G) { const int j = u >> 3, bh = (u & 7) * 2 + (j >> 4), blk = j & 15;
                    attn_unit(lds, bh >> 3, bh & 7, blk, (const bf16_t*)(ws + WS_Q), (const bf16_t*)(ws + WS_K), (const bf16_t*)(ws + WS_VT1), (const bf16_t*)(ws + WS_VT4), (const bf16_t*)(ws + WS_VT16),
                              (bf16_t*)(ws + WS_MIX), st + 2 * MTOK, wave, lane);
                    if (DUP & 1) attn_unit(lds, bh >> 3, bh & 7, blk, (const bf16_t*)(ws + WS_Q), (const bf16_t*)(ws + WS_K), (const bf16_t*)(ws + WS_VT1), (const bf16_t*)(ws + WS_VT4), (const bf16_t*)(ws + WS_VT16),
                              (bf16_t*)(ws + WS_MIX), stats + (size_t)30 * MTOK, wave, lane); } }
                SEAM(pb + 3);
            }
            if (!(SKIP & 16) && IN(pb + 4)) {
                WSBASE();
                pg8::Gemm g{(const bf16_t*)(ws + WS_MIX), (const bf16_t*)(wl + WL_OUT), MTOK, DM, DM}; pg8::StaticOrder S; S.init(MTOK, DM, G, cu);
                EpiResid<8> E{as_global(a.out), as_global(a.out), (bf16_t*)(ws + WS_XB), st + 5 * MTOK, st + 2 * MTOK, 1.0f};
                pg8::gemm_phase<EpiResid<8>, pg8::StaticOrder, true>(lds, g, S, E);
                SEAM(pb + 4);
            }
        }
    }
    if (IN(N_PHASES - 1) && !(FUSE_FINAL && G == 256)) {
        const int tid = threadIdx.x, lane = tid & 63, wave = __builtin_amdgcn_readfirstlane(tid >> 6);
        const i64* fs = (const i64*)(as_global(a.ws) + WS_STATS) + (size_t)24 * MTOK; const f32x4* gn = (const f32x4*)as_global(a.in[18]) + lane;
        for (int m = cu * NWAVES + wave; m < MTOK; m += G * NWAVES) {
            const float rs = __builtin_amdgcn_rsqf(fx_get(fs + m) * (1.0f / DM) + EPS);
            f32x4* xr = (f32x4*)(as_global(a.out) + (size_t)m * DM) + lane;
            f32x4 xv[4];
#pragma unroll
            for (int j = 0; j < 4; ++j) xv[j] = xr[64 * j] * gn[64 * j];
#pragma unroll
            for (int j = 0; j < 4; ++j) xr[64 * j] = xv[j] * rs;
        }
    }
#undef IN
#undef SEAM
#undef WSBASE
#undef IDLE_CONVERT
}

extern "C" void kernel_launch(void* const* d_in, const int* in_sizes, int n_in, void* d_out, int out_size, void* d_ws, size_t ws_size, hipStream_t stream) {
    static int grid = 0;
    if (grid == 0) {
        if (n_in != 19 || out_size != MTOK * DM || ws_size < WS_END) { fprintf(stderr, "kernel_launch: unexpected shapes (n_in %d out %d ws %zu); nothing launched\n", n_in, out_size, ws_size); grid = -1; return; }
        int dev = 0, cus = 0, per_cu = 0;
        hipGetDevice(&dev); hipDeviceGetAttribute(&cus, hipDeviceAttributeMultiprocessorCount, dev);
        if (hipFuncSetAttribute((const void*)fwd_kernel, hipFuncAttributeMaxDynamicSharedMemorySize, LDS_BYTES) != hipSuccess) { fprintf(stderr, "kernel_launch: hipFuncSetAttribute failed\n"); grid = -1; return; }
        hipOccupancyMaxActiveBlocksPerMultiprocessor(&per_cu, (const void*)fwd_kernel, NWAVES * 64, LDS_BYTES);
        (void)hipGetLastError();
        if (per_cu < 1) fprintf(stderr, "kernel_launch: occupancy query says %d blocks per CU\n", per_cu);
        grid = cus > 0 ? cus : 256;
    }
    if (grid < 0) return;
    Args a{};
    for (int i = 0; i < 19; ++i) a.in[i] = (const float*)d_in[i];
    a.out = (float*)d_out; a.ws = (unsigned char*)d_ws;
#if MK_ONE
    a.ph_lo = 0; a.ph_hi = N_PHASES;
    void* args[] = {&a};
    hipError_t e = hipLaunchCooperativeKernel((const void*)fwd_kernel, dim3(grid), dim3(NWAVES * 64), args, LDS_BYTES, stream);
    if (e != hipSuccess) fprintf(stderr, "cooperative launch failed: %s (grid %d)\n", hipGetErrorString(e), grid);
#else
    for (int p = 0; p < N_PHASES; ++p) { a.ph_lo = p; a.ph_hi = p + 1; hipLaunchKernelGGL(fwd_kernel, dim3(grid), dim3(NWAVES * 64), LDS_BYTES, stream, a); }
#endif
}
```

```cpp
#include <hip/hip_runtime.h>
#include <hip/hip_cooperative_groups.h>
#include <cstdio>
#include <cstdint>
namespace cg = cooperative_groups;

#ifndef SKIP
#define SKIP 0
#endif
#ifndef DUP
#define DUP 0
#endif
#ifndef FUSE_FINAL
#define FUSE_FINAL 1
#endif
#ifndef MK_ONE
#define MK_ONE 1
#endif

namespace pg8 {
#define PG8_LAS __attribute__((address_space(3)))
typedef unsigned short bf16_t;
typedef short bf16x8 __attribute__((ext_vector_type(8)));
typedef float f32x4 __attribute__((ext_vector_type(4)));
typedef float f32x2 __attribute__((ext_vector_type(2)));
typedef unsigned u32x4 __attribute__((ext_vector_type(4)));
typedef unsigned u32x2 __attribute__((ext_vector_type(2)));
constexpr int BM = 256, BK = 64, HALF = 128, HTB = HALF * BK * 2, STAGE_BYTES = 8 * HTB, NXCD = 8, WGM = 8;

__host__ __device__ __forceinline__ int lds_byte(int r, int c) { const int st = (r >> 4) * 2 + (c >> 5), rr = r & 15, cc = c & 31, ob = rr * 64 + cc * 2; return st * 1024 + (ob ^ (((ob >> 9) & 1) << 5)); }
__host__ __device__ __forceinline__ void stage_rc(int b, int& R, int& C) { const int st = b / 1024, sb = b % 1024, swz = sb ^ (((sb >> 9) & 1) << 5); R = (st >> 1) * 16 + swz / 64; C = (st & 1) * 32 + (swz % 64) / 2; }
__host__ __device__ __forceinline__ int perm32(int rho) { const int n = rho >> 4, i = rho & 15; return 8 * (i >> 2) + 4 * n + (i & 3); }

struct Unit { int pm, pn; };
struct Gemm { const bf16_t* A; const bf16_t* Bt; int M, N, K; };

struct StaticOrder {
    int nM, nN, nwg, G, c;
    __host__ __device__ void init(int M, int N, int G_, int c_) { nM = M / BM; nN = N / BM; nwg = nM * nN; G = G_; c = c_; }
    __host__ __device__ bool next(int i, Unit& u) const {
        const long L = (long)i * G + c; if (L >= nwg) return false;
        int wgid = (int)L; { const int q = nwg / NXCD, r = nwg % NXCD, xcd = wgid % NXCD, off = wgid / NXCD; wgid = (xcd < r ? xcd * (q + 1) : r * (q + 1) + (xcd - r) * q) + off; }
        const int nig = WGM * nN, gid = wgid / nig, fm = gid * WGM, gsz = (nM - fm) < WGM ? (nM - fm) : WGM;
        u.pm = fm + ((wgid % nig) % gsz); u.pn = (wgid % nig) / gsz; return true;
    }
};

__device__ __forceinline__ unsigned cvt_pk_bf16(float lo, float hi) { unsigned r; asm volatile("v_cvt_pk_bf16_f32 %0, %1, %2" : "=v"(r) : "v"(lo), "v"(hi)); return r; }

__device__ __forceinline__ f32x2 gelu_pk(f32x2 v) {
    const f32x2 av = __builtin_elementwise_abs(v), d = av * 0.2316418882f + 1.0f;
    f32x2 t; t.x = __builtin_amdgcn_rcpf(d.x); t.y = __builtin_amdgcn_rcpf(d.y);
    f32x2 q = t * 0.5307027145f + (-0.7265760135f); q = q * t + 0.7107068705f; q = q * t + (-0.142248368f); q = q * t + 0.127414796f; q = q * t;
    const f32x2 s = (v * v) * (-0.72134752044f);
    f32x2 e; e.x = __builtin_amdgcn_exp2f(s.x); e.y = __builtin_amdgcn_exp2f(s.y);
    const f32x2 m = v * (q * e), r = v - m;
    f32x2 o; o.x = v.x < 0.f ? m.x : r.x; o.y = v.y < 0.f ? m.y : r.y; return o;
}
__device__ __forceinline__ f32x4 gelu4(f32x4 v) { f32x2 a = gelu_pk((f32x2){v[0], v[1]}), b = gelu_pk((f32x2){v[2], v[3]}); return (f32x4){a.x, a.y, b.x, b.y}; }

template <class Epi, class Sched, bool ALIGN_EPI = false>
__device__ __forceinline__ void gemm_phase(PG8_LAS unsigned char* lds, const Gemm g, const Sched& S, const Epi& E) {
    int tid_ = threadIdx.x; asm volatile("" : "+v"(tid_));
    const int tid = tid_, wid = __builtin_amdgcn_readfirstlane(tid >> 6), lane = tid & 63, wr = wid >> 2, wc = wid & 3, fr = lane & 15, fq = lane >> 4;
    const int K = g.K, nt = K / BK;
    unsigned voffA[2], voffB[2];
#pragma unroll
    for (int i = 0; i < 2; ++i) { int R, C; stage_rc(tid * 16 + i * 8192, R, C); const int Rb = Epi::PERM ? ((R & ~31) + perm32(R & 31)) : R;
        voffA[i] = (unsigned)(R * K + C) * 2u; voffB[i] = (unsigned)(Rb * K + C) * 2u; }
    const size_t kstep = (size_t)(BK * 2);
    const size_t hstep = (size_t)HALF * K * 2;
    const size_t tstep = 2 * hstep;
    const unsigned ldsw = (unsigned)wid * 1024u;
    const int aoff = lds_byte(wr * 64 + fr, fq * 8), boff = lds_byte(wc * 32 + fr, fq * 8);
#define PG8_SA(b, h) (((b) * 2 + (h)) * HTB)
#define PG8_SB(b, h) ((4 + (b) * 2 + (h)) * HTB)
#define PG8_STAGE(bufoff, gbase, voff) do { _Pragma("unroll") for (int _i = 0; _i < 2; ++_i) \
        __builtin_amdgcn_global_load_lds((const unsigned*)((const char*)(gbase) + (voff)[_i]), (PG8_LAS unsigned*)(lds + (bufoff) + ldsw + _i * 8192), 16, 0, 0); } while (0)
#define PG8_LDA(dst, b, h) do { _Pragma("unroll") for (int m = 0; m < 4; ++m) _Pragma("unroll") for (int k = 0; k < 2; ++k) dst[m][k] = *(const PG8_LAS bf16x8*)(lds + PG8_SA(b, h) + aoff + m * 2048 + k * 1024); } while (0)
#define PG8_LDB(dst, b, h) do { _Pragma("unroll") for (int n = 0; n < 2; ++n) _Pragma("unroll") for (int k = 0; k < 2; ++k) dst[n][k] = *(const PG8_LAS bf16x8*)(lds + PG8_SB(b, h) + boff + n * 2048 + k * 1024); } while (0)
#define PG8_MMA(ai, bj, At, Bt) do { __builtin_amdgcn_s_setprio(1); _Pragma("unroll") for (int m = 0; m < 4; ++m) _Pragma("unroll") for (int n = 0; n < 2; ++n) _Pragma("unroll") for (int k = 0; k < 2; ++k) \
        acc[ai][bj][m][n] = __builtin_amdgcn_mfma_f32_16x16x32_bf16(Bt[n][k], At[m][k], acc[ai][bj][m][n], 0, 0, 0); __builtin_amdgcn_s_setprio(0); } while (0)
#define PG8_WAIT_V(n) asm volatile("s_waitcnt vmcnt(" #n ")" ::: "memory")
#define PG8_WAIT_L(n) asm volatile("s_waitcnt lgkmcnt(" #n ")" ::: "memory")
#define PG8_BAR __builtin_amdgcn_s_barrier()
#define PG8_SCHED __builtin_amdgcn_sched_barrier(0)
    Unit cur, nxt; int ui = 0;
    if (!S.next(0, cur)) return;
    f32x4 acc[2][2][4][2];
#pragma unroll
    for (int a = 0; a < 2; ++a)
#pragma unroll
        for (int b = 0; b < 2; ++b)
#pragma unroll
            for (int m = 0; m < 4; ++m)
#pragma unroll
                for (int n = 0; n < 2; ++n) acc[a][b][m][n] = (f32x4){0.f, 0.f, 0.f, 0.f};
    bf16x8 At[4][2], B0[2][2], B1[2][2];
    const char* cA = (const char*)g.A + (size_t)cur.pm * tstep; const char* cB = (const char*)g.Bt + (size_t)cur.pn * tstep;
    {
        PG8_STAGE(PG8_SB(0, 0), cB, voffB); PG8_STAGE(PG8_SB(0, 1), cB + hstep, voffB); PG8_STAGE(PG8_SA(0, 0), cA, voffA); PG8_STAGE(PG8_SA(0, 1), cA + hstep, voffA);
        if (wr == 1) PG8_BAR;
        PG8_WAIT_V(2); PG8_BAR;
        PG8_STAGE(PG8_SB(1, 0), cB + kstep, voffB); PG8_STAGE(PG8_SA(1, 0), cA + kstep, voffA); PG8_STAGE(PG8_SB(1, 1), cB + hstep + kstep, voffB);
        PG8_WAIT_V(6); PG8_BAR;
    }
    for (;;) {
        const bool has_next = S.next(ui + 1, nxt);
        const char* nA = has_next ? (const char*)g.A + (size_t)nxt.pm * tstep : cA; const char* nB = has_next ? (const char*)g.Bt + (size_t)nxt.pn * tstep : cB;
        for (int t = 0; t < nt; t += 2) {
            const bool last = (t == nt - 2);
            const char* a1 = cA + (size_t)(t + 1) * kstep;
            const char* a2 = last ? nA : cA + (size_t)(t + 2) * kstep; const char* b2 = last ? nB : cB + (size_t)(t + 2) * kstep;
            const char* a3 = a2 + kstep; const char* b3 = b2 + kstep;
            if constexpr (Epi::MID_T > 0) { if (t == Epi::MID_T) E.mid(acc, cur, wr, fr); }
            PG8_LDB(B0, 0, 0); PG8_LDB(B1, 0, 1); PG8_SCHED; PG8_LDA(At, 0, 0); PG8_STAGE(PG8_SA(1, 1), a1 + hstep, voffA);
            PG8_WAIT_V(8); PG8_WAIT_L(0); PG8_BAR; PG8_MMA(0, 0, At, B0); PG8_MMA(0, 1, At, B1); PG8_BAR; PG8_SCHED;
            PG8_LDA(At, 0, 1); PG8_STAGE(PG8_SB(0, 0), b2, voffB); PG8_STAGE(PG8_SB(0, 1), b2 + hstep, voffB); PG8_STAGE(PG8_SA(0, 0), a2, voffA);
            PG8_WAIT_V(8); PG8_WAIT_L(0); PG8_BAR; PG8_MMA(1, 0, At, B0); PG8_MMA(1, 1, At, B1); PG8_BAR; PG8_SCHED;
            PG8_LDB(B0, 1, 0); PG8_LDB(B1, 1, 1); PG8_SCHED; PG8_LDA(At, 1, 0); PG8_STAGE(PG8_SA(0, 1), a2 + hstep, voffA);
            PG8_WAIT_V(8); PG8_WAIT_L(0); PG8_BAR; PG8_MMA(0, 0, At, B0); PG8_MMA(0, 1, At, B1); PG8_BAR; PG8_SCHED;
            PG8_LDA(At, 1, 1); PG8_STAGE(PG8_SB(1, 0), b3, voffB); PG8_STAGE(PG8_SB(1, 1), b3 + hstep, voffB); PG8_STAGE(PG8_SA(1, 0), a3, voffA);
            PG8_WAIT_V(8); PG8_WAIT_L(0); PG8_BAR; PG8_MMA(1, 0, At, B0); PG8_MMA(1, 1, At, B1); PG8_BAR; PG8_SCHED;
        }
        if constexpr (ALIGN_EPI) { if (wr == 0) PG8_BAR; }
        E(acc, cur, wr, wc, fr, fq, ui);
        if (!has_next) break;
#pragma unroll
        for (int a = 0; a < 2; ++a)
#pragma unroll
            for (int b = 0; b < 2; ++b)
#pragma unroll
                for (int m = 0; m < 4; ++m)
#pragma unroll
                    for (int n = 0; n < 2; ++n) acc[a][b][m][n] = (f32x4){0.f, 0.f, 0.f, 0.f};
        cur = nxt; cA = nA; cB = nB; ++ui;
        if constexpr (ALIGN_EPI) { if (wr == 1) PG8_BAR; }
    }
    PG8_WAIT_V(0);
    if constexpr (!ALIGN_EPI) { if (wr == 0) PG8_BAR; }
    PG8_BAR;
#undef PG8_SA
#undef PG8_SB
#undef PG8_STAGE
#undef PG8_LDA
#undef PG8_LDB
#undef PG8_MMA
#undef PG8_WAIT_V
#undef PG8_WAIT_L
#undef PG8_BAR
#undef PG8_SCHED
}
}

using pg8::bf16_t; using pg8::bf16x8; using pg8::f32x4; using pg8::f32x2; using pg8::u32x4; using pg8::u32x2; using pg8::Unit; using pg8::cvt_pk_bf16;
#define LAS __attribute__((address_space(3)))
#define GAS __attribute__((address_space(1)))
template <class T> __device__ __forceinline__ T* as_global(T* p) { return (T*)(GAS T*)p; }

constexpr int MTOK = 16384, DM = 1024, SEQ = 8192, DFF = 2816, NGU = 2 * DFF, DEPTH = 4, DH = 512;
constexpr float EPS = 1e-6f, LOG2E = 1.4426950408889634f;
constexpr int NWAVES = 8;
constexpr int LDS_BYTES = 147456;

constexpr size_t MiB = 1u << 20;
constexpr size_t WS_STATS = 0;
constexpr size_t WS_ROT = 340 * MiB;
constexpr size_t WS_SGUW = 341 * MiB;
constexpr size_t WS_W = 4 * MiB;
constexpr size_t WL_GU1 = 0, WL_D1 = 11 * MiB, WL_INN = WL_D1 + 5 * MiB + 512 * 1024, WL_INS = WL_INN + 3 * MiB, WL_OUT = WL_INS + 2 * MiB, WL_GU2 = WL_OUT + 2 * MiB, WL_D2 = WL_GU2 + 11 * MiB, WL_STRIDE = 40 * MiB;
static_assert(WL_D2 + 5 * MiB + 512 * 1024 == WL_STRIDE, "weight map");
constexpr size_t WS_XB = 164 * MiB;
constexpr size_t WS_H = 196 * MiB;
constexpr size_t WS_Q = 196 * MiB, WS_K = 212 * MiB, WS_U = 228 * MiB, WS_VT1 = 244 * MiB, WS_VT4 = 260 * MiB, WS_VT16 = 276 * MiB, WS_GT = 292 * MiB, WS_MIX = 308 * MiB, WS_BAR = 342 * MiB, WS_END = 343 * MiB;
constexpr size_t BAR_BYTES = 16384;
constexpr int MISC_OFF = 143424;
constexpr int NSLOT = 26;

typedef long long i64;
constexpr float FX = 16777216.0f, FXI = 1.0f / 16777216.0f;
__device__ __forceinline__ void fx_add(i64* p, float v) { atomicAdd((unsigned long long*)p, (unsigned long long)(i64)(v * FX)); }
__device__ __forceinline__ float fx_get(const i64* p) { return (float)(*p) * FXI; }

struct Args { const float* in[19]; float* out; unsigned char* ws; int ph_lo, ph_hi; };

__device__ __forceinline__ float silu_mul(float g, float u) { return g * __builtin_amdgcn_rcpf(1.0f + __builtin_amdgcn_exp2f(-g * LOG2E)) * u; }

struct EpiSwiGLU {
    static constexpr bool PERM = true; static constexpr int MID_T = -1;
    bf16_t* H; const LAS float* rsl;
    __device__ __forceinline__ void mid(f32x4 (&)[2][2][4][2], const Unit&, int, int) const {}
    __device__ __forceinline__ void operator()(const f32x4 (&acc)[2][2][4][2], const Unit& u, int wr, int wc, int fr, int fq, int ui) const {
        const int row0 = u.pm * 256 + wr * 64 + fr, hc = u.pn * 128 + wc * 32 + 8 * fq;
#pragma unroll
        for (int ai = 0; ai < 2; ++ai)
#pragma unroll
            for (int m = 0; m < 4; ++m) {
                const int r = row0 + ai * 128 + m * 16; const float rs = rsl[ui * 256 + wr * 64 + fr + ai * 128 + m * 16];
                const f32x4 g0 = acc[ai][0][m][0] * rs, g1 = acc[ai][0][m][1] * rs, u0 = acc[ai][1][m][0] * rs, u1 = acc[ai][1][m][1] * rs;
                u32x4 w;
                w.x = cvt_pk_bf16(silu_mul(g0[0], u0[0]), silu_mul(g0[1], u0[1])); w.y = cvt_pk_bf16(silu_mul(g0[2], u0[2]), silu_mul(g0[3], u0[3]));
                w.z = cvt_pk_bf16(silu_mul(g1[0], u1[0]), silu_mul(g1[1], u1[1])); w.w = cvt_pk_bf16(silu_mul(g1[2], u1[2]), silu_mul(g1[3], u1[3]));
                *(u32x4*)(H + (size_t)r * DFF + hc) = w;
            }
    }
};

struct EpiNull {
    static constexpr bool PERM = true; static constexpr int MID_T = -1;
    __device__ __forceinline__ void mid(f32x4 (&)[2][2][4][2], const Unit&, int, int) const {}
    __device__ __forceinline__ void operator()(const f32x4 (&acc)[2][2][4][2], const Unit& u, int wr, int wc, int fr, int fq, int ui) const {
#pragma unroll
        for (int ai = 0; ai < 2; ++ai)
#pragma unroll
            for (int bj = 0; bj < 2; ++bj)
#pragma unroll
                for (int m = 0; m < 4; ++m) { asm volatile("" :: "v"(acc[ai][bj][m][0]), "v"(acc[ai][bj][m][1])); }
    }
};

template <int MIDT> struct EpiResid {
    static constexpr bool PERM = true; static constexpr int MID_T = MIDT;
    const float* Xin; float* X; bf16_t* XB; i64* ssq_out; const i64* mid_ssq; float alpha;
    __device__ __forceinline__ void mid(f32x4 (&acc)[2][2][4][2], const Unit& u, int wr, int fr) const {
        const int row0 = u.pm * 256 + wr * 64 + fr;
        i64 q[2][4];
#pragma unroll
        for (int ai = 0; ai < 2; ++ai)
#pragma unroll
            for (int m = 0; m < 4; ++m) q[ai][m] = mid_ssq[row0 + ai * 128 + m * 16];
#pragma unroll
        for (int ai = 0; ai < 2; ++ai)
#pragma unroll
            for (int m = 0; m < 4; ++m) { const float rs = __builtin_amdgcn_rsqf((float)q[ai][m] * FXI * (1.0f / DH) + EPS);
#pragma unroll
                for (int bj = 0; bj < 2; ++bj) { acc[ai][bj][m][0] = acc[ai][bj][m][0] * rs; acc[ai][bj][m][1] = acc[ai][bj][m][1] * rs; } }
    }
    __device__ __forceinline__ void operator()(const f32x4 (&acc)[2][2][4][2], const Unit& u, int wr, int wc, int fr, int fq, int ui) const {
        const int row0 = u.pm * 256 + wr * 64 + fr, col0 = u.pn * 256 + wc * 32 + 8 * fq;
#pragma unroll
        for (int ai = 0; ai < 2; ++ai) {
            f32x4 xv[4][2][2];
#pragma unroll
            for (int m = 0; m < 4; ++m)
#pragma unroll
                for (int bj = 0; bj < 2; ++bj) { const float* xp = Xin + (size_t)(row0 + ai * 128 + m * 16) * DM + col0 + bj * 128; xv[m][bj][0] = *(const f32x4*)xp; xv[m][bj][1] = *(const f32x4*)(xp + 4); }
            __builtin_amdgcn_sched_barrier(0);
#pragma unroll
            for (int m = 0; m < 4; ++m) {
                const int r = row0 + ai * 128 + m * 16; float part = 0.f;
#pragma unroll
                for (int bj = 0; bj < 2; ++bj) {
                    float* xp = X + (size_t)r * DM + col0 + bj * 128;
                    const f32x4 x0 = xv[m][bj][0] + acc[ai][bj][m][0] * alpha, x1 = xv[m][bj][1] + acc[ai][bj][m][1] * alpha;
                    *(f32x4*)xp = x0; *(f32x4*)(xp + 4) = x1;
                    part += (x0[0] * x0[0] + x0[1] * x0[1]) + (x0[2] * x0[2] + x0[3] * x0[3]) + (x1[0] * x1[0] + x1[1] * x1[1]) + (x1[2] * x1[2] + x1[3] * x1[3]);
                    u32x4 w; w.x = cvt_pk_bf16(x0[0], x0[1]); w.y = cvt_pk_bf16(x0[2], x0[3]); w.z = cvt_pk_bf16(x1[0], x1[1]); w.w = cvt_pk_bf16(x1[2], x1[3]);
                    *(u32x4*)(XB + (size_t)r * DM + col0 + bj * 128) = w;
                }
                part += __shfl_xor(part, 16); part += __shfl_xor(part, 32);
                if (fq == 0) fx_add(ssq_out + r, part);
            }
            __builtin_amdgcn_sched_barrier(0);
        }
    }
};

struct EpiFinal {
    static constexpr bool PERM = true; static constexpr int MID_T = -1;
    const float* Xin; float* Out; i64* ssq; unsigned* cnt; const float* gain; float alpha;
    __device__ __forceinline__ void mid(f32x4 (&)[2][2][4][2], const Unit&, int, int) const {}
    __device__ __forceinline__ void operator()(f32x4 (&acc)[2][2][4][2], const Unit& u, int wr, int wc, int fr, int fq, int ui) const {
        const int row0 = u.pm * 256 + wr * 64 + fr, col0 = u.pn * 256 + wc * 32 + 8 * fq;
#pragma unroll
        for (int ai = 0; ai < 2; ++ai) {
            f32x4 xv[4][2][2];
#pragma unroll
            for (int m = 0; m < 4; ++m)
#pragma unroll
                for (int bj = 0; bj < 2; ++bj) { const float* xp = Xin + (size_t)(row0 + ai * 128 + m * 16) * DM + col0 + bj * 128; xv[m][bj][0] = *(const f32x4*)xp; xv[m][bj][1] = *(const f32x4*)(xp + 4); }
            __builtin_amdgcn_sched_barrier(0);
#pragma unroll
            for (int m = 0; m < 4; ++m) {
                float part = 0.f;
#pragma unroll
                for (int bj = 0; bj < 2; ++bj) {
                    const f32x4 x0 = xv[m][bj][0] + acc[ai][bj][m][0] * alpha, x1 = xv[m][bj][1] + acc[ai][bj][m][1] * alpha;
                    acc[ai][bj][m][0] = x0; acc[ai][bj][m][1] = x1;
                    part += (x0[0] * x0[0] + x0[1] * x0[1]) + (x0[2] * x0[2] + x0[3] * x0[3]) + (x1[0] * x1[0] + x1[1] * x1[1]) + (x1[2] * x1[2] + x1[3] * x1[3]);
                }
                part += __shfl_xor(part, 16); part += __shfl_xor(part, 32);
                if (fq == 0) fx_add(ssq + row0 + ai * 128 + m * 16, part);
            }
        }
        asm volatile("s_waitcnt vmcnt(0)" ::: "memory");
        unsigned* cw = cnt + 64 * u.pm;
        if ((threadIdx.x & 63) == 0) __hip_atomic_fetch_add(cw, 1u, __ATOMIC_RELAXED, __HIP_MEMORY_SCOPE_AGENT);
        { unsigned sp = 0;
          while ((unsigned)__builtin_amdgcn_readfirstlane(__hip_atomic_load(cw, __ATOMIC_RELAXED, __HIP_MEMORY_SCOPE_AGENT)) < 32u) { __builtin_amdgcn_s_sleep(2); if (++sp > (1u << 20)) break; } }
        f32x4 gv[2][2];
#pragma unroll
        for (int bj = 0; bj < 2; ++bj) { gv[bj][0] = *(const f32x4*)(gain + col0 + bj * 128); gv[bj][1] = *(const f32x4*)(gain + col0 + bj * 128 + 4); }
        i64 q[2][4];
#pragma unroll
        for (int ai = 0; ai < 2; ++ai)
#pragma unroll
            for (int m = 0; m < 4; ++m) q[ai][m] = (i64)__hip_atomic_load((unsigned long long*)(ssq + row0 + ai * 128 + m * 16), __ATOMIC_RELAXED, __HIP_MEMORY_SCOPE_AGENT);
#pragma unroll
        for (int ai = 0; ai < 2; ++ai)
#pragma unroll
            for (int m = 0; m < 4; ++m) {
                const float rs = __builtin_amdgcn_rsqf((float)q[ai][m] * FXI * (1.0f / DM) + EPS);
                float* op = Out + (size_t)(row0 + ai * 128 + m * 16) * DM + col0;
#pragma unroll
                for (int bj = 0; bj < 2; ++bj) { *(f32x4*)(op + bj * 128) = acc[ai][bj][m][0] * rs * gv[bj][0]; *(f32x4*)(op + bj * 128 + 4) = acc[ai][bj][m][1] * rs * gv[bj][1]; }
            }
    }
};

struct EpiQKU {
    static constexpr bool PERM = true; static constexpr int MID_T = -1;
    bf16_t *Q; const LAS float* rsl; const float* rcos; const float* rsin;
    __device__ __forceinline__ void mid(f32x4 (&)[2][2][4][2], const Unit&, int, int) const {}
    __device__ __forceinline__ void operator()(const f32x4 (&acc)[2][2][4][2], const Unit& u, int wr, int wc, int fr, int fq, int ui) const {
        const int sect = u.pn >> 1; bf16_t* base = Q + (size_t)sect * 8388608;
        const int row0 = u.pm * 256 + wr * 64 + fr, colt = (u.pn & 1) * 256 + wc * 32 + 8 * fq;
        const bool rot = (sect < 2) && ((wc & 1) == 0);
        const float sgn = (fq == 0) ? -1.f : 1.f; const float osc = (sect == 0) ? 0.125f * LOG2E : 1.f;
#pragma unroll
        for (int ai = 0; ai < 2; ++ai)
#pragma unroll
            for (int m = 0; m < 4; ++m) {
                const int r = row0 + ai * 128 + m * 16; const float rs = rsl[ui * 256 + wr * 64 + fr + ai * 128 + m * 16];
                const int pos = r & (SEQ - 1);
                f32x4 c0, c1, s0, s1;
                if (rot) { c0 = *(const f32x4*)(rcos + pos * 8); c1 = *(const f32x4*)(rcos + pos * 8 + 4); s0 = *(const f32x4*)(rsin + pos * 8); s1 = *(const f32x4*)(rsin + pos * 8 + 4); }
#pragma unroll
                for (int bj = 0; bj < 2; ++bj) {
                    f32x4 v0 = acc[ai][bj][m][0] * rs, v1 = acc[ai][bj][m][1] * rs;
                    if (sect == 2) { v0 = pg8::gelu4(v0); v1 = pg8::gelu4(v1); }
                    else {
                        if (rot) {
                            f32x4 p0, p1;
#pragma unroll
                            for (int i = 0; i < 4; ++i) { p0[i] = __shfl_xor(v0[i], 16); p1[i] = __shfl_xor(v1[i], 16); }
                            if (fq < 2) { v0 = v0 * c0 + p0 * s0 * sgn; v1 = v1 * c1 + p1 * s1 * sgn; }
                        }
                        v0 = v0 * osc; v1 = v1 * osc;
                    }
                    u32x4 w; w.x = cvt_pk_bf16(v0[0], v0[1]); w.y = cvt_pk_bf16(v0[2], v0[3]); w.z = cvt_pk_bf16(v1[0], v1[1]); w.w = cvt_pk_bf16(v1[2], v1[3]);
                    const int cc = colt + bj * 128;
                    if (sect == 2) *(u32x4*)(base + (size_t)r * DH + cc) = w;
                    else *(u32x4*)(base + ((size_t)((r >> 13) * 8 + (cc >> 6)) * SEQ + (r & (SEQ - 1))) * 64 + (cc & 63)) = w;
                }
            }
    }
};

struct EpiVG {
    static constexpr bool PERM = true; static constexpr int MID_T = -1;
    bf16_t *Vt1, *Vt4, *Vt16, *Gt; const LAS float* rsl; i64* lnsum; i64* lnsq;
    __device__ __forceinline__ void mid(f32x4 (&)[2][2][4][2], const Unit&, int, int) const {}
    __device__ __forceinline__ void operator()(const f32x4 (&acc)[2][2][4][2], const Unit& u, int wr, int wc, int fr, int fq, int ui) const {
        const int sect = u.pm >> 1;
        const int ch0 = (u.pm & 1) * 256 + wr * 64 + fr;
#pragma unroll
        for (int bj = 0; bj < 2; ++bj) {
            const int tok = u.pn * 256 + wc * 32 + 8 * fq + bj * 128;
            const LAS float* rp = rsl + ui * 256 + wc * 32 + 8 * fq + bj * 128;
            const f32x4 rs0 = *(const LAS f32x4*)rp, rs1 = *(const LAS f32x4*)(rp + 4);
            if (sect == 0) {
                const int b_ = tok >> 13, t0 = tok & (SEQ - 1);
#pragma unroll
                for (int ai = 0; ai < 2; ++ai)
#pragma unroll
                    for (int m = 0; m < 4; ++m) {
                        const int ch = ch0 + ai * 128 + m * 16;
                        const size_t bhb = (size_t)(b_ * 8 + (ch >> 6)) * (SEQ * 64) + (size_t)(ch & 63) * 8;
                        const f32x4 v0 = acc[ai][bj][m][0] * rs0, v1 = acc[ai][bj][m][1] * rs1;
                        u32x4 w; w.x = cvt_pk_bf16(v0[0], v0[1]); w.y = cvt_pk_bf16(v0[2], v0[3]); w.z = cvt_pk_bf16(v1[0], v1[1]); w.w = cvt_pk_bf16(v1[2], v1[3]);
                        *(u32x4*)(Vt1 + bhb + (size_t)(t0 >> 3) * 512) = w;
                        { const unsigned a0 = cvt_pk_bf16(v0[0], v1[0]), a1 = cvt_pk_bf16(v0[1], v1[1]), a2 = cvt_pk_bf16(v0[2], v1[2]), a3 = cvt_pk_bf16(v0[3], v1[3]);
                          const bool odd = fq & 1;
                          const unsigned s0 = odd ? a0 : a2, s1 = odd ? a1 : a3;
                          const unsigned r0 = (unsigned)__shfl_xor((int)s0, 16), r1 = (unsigned)__shfl_xor((int)s1, 16);
                          const int n = (t0 & ~15) >> 2, rb = odd ? 2 : 0;
                          bf16_t* p4 = Vt4 + bhb + (size_t)(rb * 256 + (n >> 3)) * 512 + (n & 7);
                          u32x2 q0, q1; q0.x = odd ? r0 : a0; q0.y = odd ? a2 : r0; q1.x = odd ? r1 : a1; q1.y = odd ? a3 : r1;
                          *(u32x2*)p4 = q0; *(u32x2*)(p4 + (size_t)256 * 512) = q1; }
                        { const bool hi = fq & 2;
                          const unsigned s0 = hi ? w.x : w.z, s1 = hi ? w.y : w.w;
                          const unsigned r0 = (unsigned)__shfl_xor((int)s0, 32), r1 = (unsigned)__shfl_xor((int)s1, 32);
                          const unsigned lo0 = hi ? r0 : w.x, lo1 = hi ? r1 : w.y, hi0 = hi ? w.z : r0, hi1 = hi ? w.w : r1;
                          const int n = (t0 & ~31) >> 4, rb = (t0 & 8) + (hi ? 4 : 0);
                          bf16_t* p16 = Vt16 + bhb + (size_t)(rb * 64 + (n >> 3)) * 512 + (n & 7);
                          *(unsigned*)(p16 + (size_t)0 * 64 * 512) = (lo0 & 0xffffu) | (hi0 << 16);
                          *(unsigned*)(p16 + (size_t)1 * 64 * 512) = (lo0 >> 16) | (hi0 & 0xffff0000u);
                          *(unsigned*)(p16 + (size_t)2 * 64 * 512) = (lo1 & 0xffffu) | (hi1 << 16);
                          *(unsigned*)(p16 + (size_t)3 * 64 * 512) = (lo1 >> 16) | (hi1 & 0xffff0000u); }
                    }
            } else {
                f32x4 sm0 = (f32x4){0.f, 0.f, 0.f, 0.f}, sm1 = sm0, sq0 = sm0, sq1 = sm0;
#pragma unroll
                for (int ai = 0; ai < 2; ++ai)
#pragma unroll
                    for (int m = 0; m < 4; ++m) {
                        const int ch = ch0 + ai * 128 + m * 16;
                        const f32x4 v0 = pg8::gelu4(acc[ai][bj][m][0] * rs0), v1 = pg8::gelu4(acc[ai][bj][m][1] * rs1);
                        sm0 = sm0 + v0; sm1 = sm1 + v1; sq0 = sq0 + v0 * v0; sq1 = sq1 + v1 * v1;
                        u32x4 w; w.x = cvt_pk_bf16(v0[0], v0[1]); w.y = cvt_pk_bf16(v0[2], v0[3]); w.z = cvt_pk_bf16(v1[0], v1[1]); w.w = cvt_pk_bf16(v1[2], v1[3]);
                        *(u32x4*)(Gt + ((size_t)(tok >> 3) * 512 + ch) * 8) = w;
                    }
#pragma unroll
                for (int i = 0; i < 4; ++i) {
                    float a0 = sm0[i], a1 = sm1[i], b0 = sq0[i], b1 = sq1[i];
#pragma unroll
                    for (int o = 1; o < 16; o <<= 1) { a0 += __shfl_xor(a0, o); a1 += __shfl_xor(a1, o); b0 += __shfl_xor(b0, o); b1 += __shfl_xor(b1, o); }
                    if (fr == 0) { fx_add(lnsum + tok + i, a0); fx_add(lnsum + tok + 4 + i, a1); fx_add(lnsq + tok + i, b0); fx_add(lnsq + tok + 4 + i, b1); }
                }
            }
        }
    }
};

__device__ __forceinline__ float wave_sum(float v) {
#pragma unroll
    for (int o = 1; o < 64; o <<= 1) v += __shfl_xor(v, o);
    return v;
}
__device__ __forceinline__ void transpose_item(const float* W, int Nsrc, int nsrc0, int k0, int K, bf16_t* WT, int drow0, const float* gain, LAS float* scr, int lane) {
    f32x4 v[16];
#pragma unroll
    for (int i = 0; i < 16; ++i) v[i] = __builtin_nontemporal_load((const f32x4*)(W + (size_t)(k0 + 4 * i + (lane >> 4)) * Nsrc + nsrc0 + 4 * (lane & 15)));
#pragma unroll
    for (int i = 0; i < 16; ++i) { const int kk = 4 * i + (lane >> 4); const float gsc = gain ? gain[kk] : 1.0f; LAS float* d = scr + kk * 65 + 4 * (lane & 15);
        d[0] = v[i][0] * gsc; d[1] = v[i][1] * gsc; d[2] = v[i][2] * gsc; d[3] = v[i][3] * gsc; }
    asm volatile("s_waitcnt lgkmcnt(0)" ::: "memory");
    const int c = lane & 7;
#pragma unroll
    for (int j = 0; j < 8; ++j) { const int n = (lane >> 3) + 8 * j; const LAS float* s = scr + (8 * c) * 65 + n;
        u32x4 o; o.x = cvt_pk_bf16(s[0 * 65], s[1 * 65]); o.y = cvt_pk_bf16(s[2 * 65], s[3 * 65]); o.z = cvt_pk_bf16(s[4 * 65], s[5 * 65]); o.w = cvt_pk_bf16(s[6 * 65], s[7 * 65]);
        *(u32x4*)(WT + (size_t)(drow0 + n) * K + k0 + 8 * c) = o; }
    asm volatile("s_waitcnt lgkmcnt(0)" ::: "memory");
}

constexpr int I_GU = 16 * (NGU / 64), I_D = (DFF / 64) * 16, I_INN = 16 * 24, I_INS = 16 * 16, I_OUT = 16 * 16;
constexpr int I_LAYER = 2 * I_GU + 2 * I_D + I_INN + I_INS + I_OUT;
__device__ __forceinline__ void convert_weights(const Args& a, LAS unsigned char* lds, int l, int it_lo, int it_hi, int w, int NW, int wave, int lane) {
    unsigned char* ws = as_global(a.ws);
    LAS float* scr = (LAS float*)(lds + wave * 16640);
    unsigned char* wl = ws + WS_W + (size_t)l * WL_STRIDE;
    for (int it = it_lo + w; it < it_hi; it += NW) {
        int r = it;
        if (r < 2 * I_GU) {
            const int f = r / I_GU; r %= I_GU;
            const int kb = r / (NGU / 64), nb = r % (NGU / 64), n0d = 64 * nb, hb = n0d >> 7;
            const float* src = (hb & 1) ? as_global(a.in[f ? 16 : 3]) : as_global(a.in[f ? 15 : 2]);
            transpose_item(src + (size_t)l * DM * DFF, DFF, (hb >> 1) * 128 + (n0d & 127), 64 * kb, DM, (bf16_t*)(wl + (f ? WL_GU2 : WL_GU1)), n0d, as_global(a.in[f ? 14 : 1]) + l * DM + 64 * kb, scr, lane);
            continue;
        }
        r -= 2 * I_GU;
        if (r < 2 * I_D) {
            const int f = r / I_D; r %= I_D;
            const int kb = r / 16, nb = r % 16;
            transpose_item(as_global(a.in[f ? 17 : 4]) + (size_t)l * DFF * DM, DM, 64 * nb, 64 * kb, DFF, (bf16_t*)(wl + (f ? WL_D2 : WL_D1)), 64 * nb, nullptr, scr, lane);
            continue;
        }
        r -= 2 * I_D;
        if (r < I_INN) {
            const int kb = r / 24, nb = r % 24, n0d = 64 * nb;
            transpose_item(as_global(a.in[6]) + (size_t)l * DM * 2560, 2560, n0d < 1024 ? n0d : n0d + 512, 64 * kb, DM, (bf16_t*)(wl + WL_INN), n0d, as_global(a.in[5]) + l * DM + 64 * kb, scr, lane);
            continue;
        }
        r -= I_INN;
        if (r < I_INS) {
            const int kb = r / 16, nb = r % 16, n0d = 64 * nb;
            transpose_item(as_global(a.in[6]) + (size_t)l * DM * 2560, 2560, n0d < 512 ? 1024 + n0d : 1536 + n0d, 64 * kb, DM, (bf16_t*)(wl + WL_INS), n0d, as_global(a.in[5]) + l * DM + 64 * kb, scr, lane);
            continue;
        }
        r -= I_INS;
        {
            const int kb = r / 16, nb = r % 16, k0 = 64 * kb;
            const float* gain = k0 < 512 ? as_global(a.in[11]) + l * DH + k0 : as_global(a.in[12]) + l * DH + (k0 - 512);
            transpose_item(as_global(a.in[13]) + (size_t)l * DM * DM, DM, 64 * nb, k0, DM, (bf16_t*)(wl + WL_OUT), 64 * nb, gain, scr, lane);
        }
    }
}

__device__ __forceinline__ void prologue(const Args& a, LAS unsigned char* lds, int gw, int NGW, int wave, int lane, int nlayers) {
    unsigned char* ws = as_global(a.ws);
    float* outp = as_global(a.out);
    if (nlayers < 0) convert_weights(a, lds, 0, 0, I_GU, gw, NGW, wave, lane);
    else
#pragma unroll 1
    for (int l = 0; l < nlayers; ++l) convert_weights(a, lds, l, 0, I_LAYER, gw, NGW, wave, lane);
    i64* stats = (i64*)(ws + WS_STATS);
    for (int m = gw; m < MTOK; m += NGW) {
        const f32x4* xr = (const f32x4*)(as_global(a.in[0]) + (size_t)m * DM) + lane;
        u32x2* xb = (u32x2*)((bf16_t*)(ws + WS_XB) + (size_t)m * DM) + lane;
        float s = 0.f; f32x4 xin[4];
#pragma unroll
        for (int j = 0; j < 4; ++j) xin[j] = xr[64 * j];
#pragma unroll
        for (int j = 0; j < 4; ++j) { const f32x4 v = xin[j]; s += (v[0] * v[0] + v[1] * v[1]) + (v[2] * v[2] + v[3] * v[3]);
            u32x2 w; w.x = cvt_pk_bf16(v[0], v[1]); w.y = cvt_pk_bf16(v[2], v[3]); xb[64 * j] = w; }
        s = wave_sum(s);
        if (lane == 0) stats[m] = (i64)(s * FX);
    }
    { const int gt = gw * 64 + lane, NGT = NGW * 64;
      for (int i = gt; i < (NSLOT - 1) * MTOK / 2; i += NGT) ((f32x4*)(stats + MTOK))[i] = (f32x4){0.f, 0.f, 0.f, 0.f};
      float* rc = (float*)(ws + WS_ROT); float* rsn = rc + SEQ * 8;
      for (int i = gt; i < SEQ * 8; i += NGT) { const int pos = i >> 3, j = i & 7;
          const float inv = exp2f(-(float)j * 2.36644607116552f);
          const float ang = (float)pos * inv;
          const double rev = (double)ang * 0.15915494309189535; const float fr_ = (float)(rev - floor(rev));
          rc[i] = __builtin_amdgcn_cosf(fr_); rsn[i] = __builtin_amdgcn_sinf(fr_); }
      bf16_t* sw = (bf16_t*)(ws + WS_SGUW);
      for (int i = gt; i < DEPTH * 4 * 128 * 128 / 4; i += NGT) { const f32x4 v = ((const f32x4*)as_global(a.in[9]))[i]; u32x2 w; w.x = cvt_pk_bf16(v[0], v[1]); w.y = cvt_pk_bf16(v[2], v[3]); ((u32x2*)sw)[i] = w; }
    }
}

constexpr int OP = 68;
constexpr int ABLK = 512;
__device__ __forceinline__ void attn_unit(LAS unsigned char* lds, int b, int h, int blk, const bf16_t* Q, const bf16_t* Kb, const bf16_t* Vt1, const bf16_t* Vt4, const bf16_t* Vt16,
                                          bf16_t* MIX, i64* ssq_a, int wid, int lane_in) {
    int lane = lane_in; asm volatile("" : "+v"(lane));
    LAS float* Oacc = (LAS float*)lds; LAS float* Ml = Oacc + ABLK * OP;
    const int qi = lane & 15, kq = lane >> 4, T0 = blk * ABLK;
    const size_t tb = (size_t)b * SEQ; const size_t bhb = (size_t)(b * 8 + h) * (SEQ * 64);
#pragma unroll 1
    for (int p = 0; p < 3; ++p) {
        const int lg = 2 * p, L = SEQ >> lg;
        const bf16_t* Vt = p == 0 ? Vt1 : (p == 1 ? Vt4 : Vt16);
#pragma unroll 1
        for (int it = 0; it < 2; ++it) {
            const int pi = wid * 2 + it;
            int r, n0;
            if (p == 0) { r = 0; n0 = T0 + 32 * pi; } else if (p == 1) { r = pi >> 2; n0 = (T0 >> 2) + 32 * (pi & 3); } else { r = pi; n0 = T0 >> 4; }
            const int ws_ = n0 - 64;
            int qtok[2]; bf16x8 qf[2][2];
#pragma unroll
            for (int g = 0; g < 2; ++g) { qtok[g] = ((n0 + 16 * g + qi) << lg) + r; const bf16_t* qp = Q + bhb + (size_t)qtok[g] * 64 + kq * 16; qf[g][0] = *(const bf16x8*)qp; qf[g][1] = *(const bf16x8*)(qp + 8); }
            bf16x8 kf[10][2];
#pragma unroll
            for (int t = 0; t < 10; ++t) {
                const int widx = 32 * (t >> 1) + 8 * (qi >> 2) + 4 * (t & 1) + (qi & 3);
                int kn = ws_ + widx; kn = kn < 0 ? 0 : (kn > L - 1 ? L - 1 : kn);
                const bf16_t* kp = Kb + bhb + (size_t)((kn << lg) + r) * 64 + kq * 16;
                kf[t][0] = *(const bf16x8*)kp; kf[t][1] = *(const bf16x8*)(kp + 8);
            }
            __builtin_amdgcn_sched_barrier(0);
            f32x4 s[2][10];
#pragma unroll
            for (int t = 0; t < 10; ++t)
#pragma unroll
                for (int g = 0; g < 2; ++g) {
                    f32x4 z = (f32x4){0.f, 0.f, 0.f, 0.f};
                    z = __builtin_amdgcn_mfma_f32_16x16x32_bf16(kf[t][0], qf[g][0], z, 0, 0, 0);
                    z = __builtin_amdgcn_mfma_f32_16x16x32_bf16(kf[t][1], qf[g][1], z, 0, 0, 0);
                    s[g][t] = z;
                }
            __builtin_amdgcn_sched_barrier(0);
            bf16x8 vf[5][4];
#pragma unroll
            for (int c = 0; c < 5; ++c) {
                int gk = ws_ + 32 * c + 8 * kq; gk = (gk < 0 || gk >= L) ? 0 : gk;
                const bf16_t* vp = Vt + bhb + ((size_t)(r * (L >> 3) + (gk >> 3)) * 64 + qi) * 8;
#pragma unroll
                for (int dt = 0; dt < 4; ++dt) vf[c][dt] = *(const bf16x8*)(vp + dt * 128);
            }
            __builtin_amdgcn_sched_barrier(0);
            float mx[2], lsum[2];
#pragma unroll
            for (int g = 0; g < 2; ++g) {
                float m_ = -1e30f;
                int lo = 16 * g + qi, hi = 128 + 16 * g + qi; lo = lo > -ws_ ? lo : -ws_; hi = hi < L - 1 - ws_ ? hi : L - 1 - ws_;
                const int lo8 = lo - 8 * kq; const unsigned span = (unsigned)(hi - lo);
#pragma unroll
                for (int t = 0; t < 10; ++t)
#pragma unroll
                    for (int i = 0; i < 4; ++i) {
                        const int c = 32 * (t >> 1) + 4 * (t & 1) + i;
                        const bool ok = (unsigned)(c - lo8) <= span;
                        const float v = ok ? s[g][t][i] : -1e30f; s[g][t][i] = v; m_ = fmaxf(m_, v);
                    }
                m_ = fmaxf(m_, __shfl_xor(m_, 16)); m_ = fmaxf(m_, __shfl_xor(m_, 32));
                float l_ = 0.f;
#pragma unroll
                for (int t = 0; t < 10; ++t)
#pragma unroll
                    for (int i = 0; i < 4; ++i) { const float pv = __builtin_amdgcn_exp2f(s[g][t][i] - m_); s[g][t][i] = pv; l_ += pv; }
                l_ += __shfl_xor(l_, 16); l_ += __shfl_xor(l_, 32);
                mx[g] = m_; lsum[g] = l_;
            }
            f32x4 o[2][4];
#pragma unroll
            for (int g = 0; g < 2; ++g)
#pragma unroll
                for (int dt = 0; dt < 4; ++dt) o[g][dt] = (f32x4){0.f, 0.f, 0.f, 0.f};
#pragma unroll
            for (int c = 0; c < 5; ++c)
#pragma unroll
                for (int g = 0; g < 2; ++g) {
                    union { u32x4 u; bf16x8 v; } pf;
                    pf.u.x = cvt_pk_bf16(s[g][2 * c][0], s[g][2 * c][1]); pf.u.y = cvt_pk_bf16(s[g][2 * c][2], s[g][2 * c][3]);
                    pf.u.z = cvt_pk_bf16(s[g][2 * c + 1][0], s[g][2 * c + 1][1]); pf.u.w = cvt_pk_bf16(s[g][2 * c + 1][2], s[g][2 * c + 1][3]);
#pragma unroll
                    for (int dt = 0; dt < 4; ++dt) o[g][dt] = __builtin_amdgcn_mfma_f32_16x16x32_bf16(vf[c][dt], pf.v, o[g][dt], 0, 0, 0);
                }
#pragma unroll
            for (int g = 0; g < 2; ++g) {
                const int tl = qtok[g] - T0;
                LAS float* orow = Oacc + tl * OP + 4 * kq;
                if (p == 0) {
#pragma unroll
                    for (int dt = 0; dt < 4; ++dt) *(LAS f32x4*)(orow + 16 * dt) = o[g][dt];
                    if (kq == 0) { Ml[2 * tl] = mx[g]; Ml[2 * tl + 1] = lsum[g]; }
                } else {
                    const float mo = Ml[2 * tl], lo = Ml[2 * tl + 1];
                    const float mn = fmaxf(mo, mx[g]), fa = __builtin_amdgcn_exp2f(mo - mn), fb = __builtin_amdgcn_exp2f(mx[g] - mn);
                    f32x4 om[4];
#pragma unroll
                    for (int dt = 0; dt < 4; ++dt) om[dt] = *(const LAS f32x4*)(orow + 16 * dt) * fa + o[g][dt] * fb;
                    const float ln = lo * fa + lsum[g] * fb;
                    asm volatile("s_waitcnt lgkmcnt(0)" ::: "memory");
#pragma unroll
                    for (int dt = 0; dt < 4; ++dt) *(LAS f32x4*)(orow + 16 * dt) = om[dt];
                    if (kq == 0) { Ml[2 * tl] = mn; Ml[2 * tl + 1] = ln; }
                }
            }
        }
        __syncthreads();
    }
#pragma unroll 1
    for (int ps = 0; ps < ABLK / 256; ++ps) {
      const int tid = wid * 64 + lane, tl = ps * 256 + (tid >> 1), half = tid & 1;
      const float inv = 1.0f / Ml[2 * tl + 1]; const LAS float* orow = Oacc + tl * OP + 32 * half; float part = 0.f;
      bf16_t* op = MIX + (tb + T0 + tl) * DM + h * 64 + 32 * half;
#pragma unroll
      for (int j = 0; j < 4; ++j) { const f32x4 va = *(const LAS f32x4*)(orow + 8 * j) * inv, vb = *(const LAS f32x4*)(orow + 8 * j + 4) * inv;
          part += (va[0] * va[0] + va[1] * va[1]) + (va[2] * va[2] + va[3] * va[3]) + (vb[0] * vb[0] + vb[1] * vb[1]) + (vb[2] * vb[2] + vb[3] * vb[3]);
          u32x4 w; w.x = cvt_pk_bf16(va[0], va[1]); w.y = cvt_pk_bf16(va[2], va[3]); w.z = cvt_pk_bf16(vb[0], vb[1]); w.w = cvt_pk_bf16(vb[2], vb[3]); *(u32x4*)(op + 8 * j) = w; }
      part += __shfl_xor(part, 1);
      if (half == 0) fx_add(ssq_a + tb + T0 + tl, part);
    }
    __syncthreads();
}

constexpr int SGU_TAB = 131072;
__device__ __forceinline__ void sgu_unit(LAS unsigned char* lds, int tok0, const bf16_t* Gt, const bf16_t* U, const bf16_t* Wb, const float* bs, const float* lng, const float* lnb,
                                         const i64* lnsum, const i64* lnsq, bf16_t* MIX, int wid, int lane_in) {
    int lane = lane_in; asm volatile("" : "+v"(lane));
    LAS float* MU = (LAS float*)(lds + SGU_TAB); LAS float* RS = MU + 128; LAS float* SS = RS + 128;
    const int tid = wid * 64 + lane;
#pragma unroll
    for (int i = 0; i < 16; ++i) { const int P = ((i * 8 + wid) << 6) + lane, row = P >> 4, piece = (P & 15) ^ (row & 15);
        __builtin_amdgcn_global_load_lds((const unsigned*)(Wb + (size_t)row * 128 + piece * 8), (LAS unsigned*)(lds + (i * 8 + wid) * 1024), 16, 0, 0); }
    const int g = wid >> 1, e0 = 64 * (wid & 1), li = lane & 15, kq = lane >> 4;
    float gg[4], gb[4]; u32x4 rawg[4][4];
#pragma unroll
    for (int et = 0; et < 4; ++et) { const int ch = g * 128 + e0 + 16 * (li >> 2) + 4 * et + (li & 3);
        gg[et] = lng[ch]; gb[et] = lnb[ch];
#pragma unroll
        for (int c = 0; c < 4; ++c) rawg[c][et] = *(const u32x4*)(Gt + ((size_t)((tok0 + 32 * c + 8 * kq) >> 3) * 512 + ch) * 8); }
    if (tid < 128) { const float sm = fx_get(lnsum + tok0 + tid) * (1.0f / DH); const float var = fx_get(lnsq + tok0 + tid) * (1.0f / DH) - sm * sm;
        MU[tid] = sm; RS[tid] = __builtin_amdgcn_rsqf(fmaxf(var, 0.f) + EPS); }
    asm volatile("s_waitcnt vmcnt(0)" ::: "memory");
    __syncthreads();
    f32x4 acc[4][8];
#pragma unroll
    for (int et = 0; et < 4; ++et)
#pragma unroll
        for (int tt = 0; tt < 8; ++tt) acc[et][tt] = (f32x4){0.f, 0.f, 0.f, 0.f};
    const LAS unsigned char* wrow = lds + (size_t)(g * 128 + li) * 256;
#pragma unroll
    for (int c = 0; c < 4; ++c) {
        const int s0 = 32 * c + 8 * kq;
        const f32x4 mu0 = *(const LAS f32x4*)(MU + s0), mu1 = *(const LAS f32x4*)(MU + s0 + 4), rs0 = *(const LAS f32x4*)(RS + s0), rs1 = *(const LAS f32x4*)(RS + s0 + 4);
        bf16x8 af[4];
#pragma unroll
        for (int et = 0; et < 4; ++et) {
            const u32x4 raw = rawg[c][et];
            f32x4 x0, x1;
            x0[0] = __uint_as_float(raw.x << 16); x0[1] = __uint_as_float(raw.x & 0xffff0000u); x0[2] = __uint_as_float(raw.y << 16); x0[3] = __uint_as_float(raw.y & 0xffff0000u);
            x1[0] = __uint_as_float(raw.z << 16); x1[1] = __uint_as_float(raw.z & 0xffff0000u); x1[2] = __uint_as_float(raw.w << 16); x1[3] = __uint_as_float(raw.w & 0xffff0000u);
            x0 = (x0 - mu0) * rs0 * gg[et] + gb[et]; x1 = (x1 - mu1) * rs1 * gg[et] + gb[et];
            union { u32x4 u; bf16x8 v; } pk;
            pk.u.x = cvt_pk_bf16(x0[0], x0[1]); pk.u.y = cvt_pk_bf16(x0[2], x0[3]); pk.u.z = cvt_pk_bf16(x1[0], x1[1]); pk.u.w = cvt_pk_bf16(x1[2], x1[3]);
            af[et] = pk.v;
        }
#pragma unroll
        for (int tt = 0; tt < 8; ++tt) {
            const bf16x8 wf = *(const LAS bf16x8*)(wrow + tt * 4096 + (((4 * c + kq) ^ li) << 4));
#pragma unroll
            for (int et = 0; et < 4; ++et) acc[et][tt] = __builtin_amdgcn_mfma_f32_16x16x32_bf16(af[et], wf, acc[et][tt], 0, 0, 0);
        }
    }
    u32x4 uraw[8][2]; float biasv[8];
#pragma unroll
    for (int tt = 0; tt < 8; ++tt) { biasv[tt] = bs[g * 128 + 16 * tt + li];
        const bf16_t* up = U + (size_t)(tok0 + 16 * tt + li) * DH + g * 128 + e0 + 16 * kq;
        uraw[tt][0] = *(const u32x4*)up; uraw[tt][1] = *(const u32x4*)(up + 8); }
    __builtin_amdgcn_sched_barrier(0);
#pragma unroll
    for (int tt = 0; tt < 8; ++tt) {
        const int t = 16 * tt + li; const float bias = biasv[tt]; float part = 0.f;
#pragma unroll
        for (int et = 0; et < 4; ++et) {
            const unsigned r0 = (et & 1) ? uraw[tt][et >> 1].z : uraw[tt][et >> 1].x, r1 = (et & 1) ? uraw[tt][et >> 1].w : uraw[tt][et >> 1].y;
            f32x4 uv; uv[0] = __uint_as_float(r0 << 16); uv[1] = __uint_as_float(r0 & 0xffff0000u); uv[2] = __uint_as_float(r1 << 16); uv[3] = __uint_as_float(r1 & 0xffff0000u);
            const f32x4 v = uv * (acc[et][tt] + bias); acc[et][tt] = v;
            part += (v[0] * v[0] + v[1] * v[1]) + (v[2] * v[2] + v[3] * v[3]);
        }
        part += __shfl_xor(part, 16); part += __shfl_xor(part, 32);
        if (kq == 0) SS[wid * 128 + t] = part;
    }
    __syncthreads();
#pragma unroll
    for (int tt = 0; tt < 8; ++tt) {
        const int t = 16 * tt + li; float tot = 0.f;
#pragma unroll
        for (int w8 = 0; w8 < 8; ++w8) tot += SS[w8 * 128 + t];
        const float rstd = __builtin_amdgcn_rsqf(tot * (1.0f / DH) + EPS);
        bf16_t* mp = MIX + (size_t)(tok0 + t) * DM + DH + g * 128 + e0 + 16 * kq;
#pragma unroll
        for (int eh = 0; eh < 2; ++eh) { const f32x4 va = acc[2 * eh][tt] * rstd, vb = acc[2 * eh + 1][tt] * rstd;
            u32x4 w; w.x = cvt_pk_bf16(va[0], va[1]); w.y = cvt_pk_bf16(va[2], va[3]); w.z = cvt_pk_bf16(vb[0], vb[1]); w.w = cvt_pk_bf16(vb[2], vb[3]); *(u32x4*)(mp + 8 * eh) = w; }
    }
    __syncthreads();
}

#define XB_TMO      128
#define XB_XCNT(j)  (256  + 64 * (j))
#define XB_XSUB(j)  (1280 + 64 * (j))
#define XB_XGEN(j)  (2304 + 64 * (j))
#define XB_TOP      3328
#define XB_TOPGEN   3392
#define XCD_BAR_WORDS 3456
#define XB_SPIN_CAP (1u << 18)

__device__ __forceinline__ unsigned xb_ld(unsigned* p)              { return __hip_atomic_load(p, __ATOMIC_RELAXED, __HIP_MEMORY_SCOPE_AGENT); }
__device__ __forceinline__ unsigned xb_add(unsigned* p, unsigned v) { return __hip_atomic_fetch_add(p, v, __ATOMIC_RELAXED, __HIP_MEMORY_SCOPE_AGENT); }
__device__ __forceinline__ unsigned xb_xcc_id() { return (unsigned)__builtin_amdgcn_s_getreg((3 << 11) | 20) & 0xFu; }
#define XB_SPIN(cond, bar) do { unsigned _sp = 0; while (cond) { __builtin_amdgcn_s_sleep(1); \
    if ((++_sp & 255u) == 0u) { if (xb_ld(&(bar)[XB_TMO])) break; if (_sp > XB_SPIN_CAP) { atomicAdd(&(bar)[XB_TMO], 1u); break; } } } } while (0)

struct XcdBarrier {
    unsigned* bar; unsigned x;
    volatile LAS unsigned* st;
};

__device__ __forceinline__ XcdBarrier xcd_barrier_post(unsigned* bar, volatile LAS unsigned* st) {
    XcdBarrier b; b.bar = bar; b.x = xb_xcc_id(); b.st = st;
    if (threadIdx.x == 0) (void)xb_add(&bar[XB_XCNT(b.x)], 1u);
    return b;
}
__device__ __forceinline__ void xcd_barrier_complete(unsigned* bar, unsigned x, unsigned& nloc, unsigned& nx) {
    const unsigned G = gridDim.x * gridDim.y * gridDim.z;
    unsigned sum, cnt, mine, sp = 0u;
    for (;;) {
        sum = 0u; cnt = 0u; mine = 0u;
#pragma unroll
        for (unsigned j = 0; j < 16; ++j) { const unsigned c = xb_ld(&bar[XB_XCNT(j)]); sum += c; cnt += (c > 0u) ? 1u : 0u; mine = (j == x) ? c : mine; }
        if (sum == G) break;
        __builtin_amdgcn_s_sleep(1);
        if ((++sp & 255u) == 0u) { if (xb_ld(&bar[XB_TMO])) break; if (sp > XB_SPIN_CAP) { atomicAdd(&bar[XB_TMO], 1u); break; } }
    }
    nloc = mine > 0u ? mine : 1u; nx = cnt > 0u ? cnt : 1u;
}

__device__ __forceinline__ void xcd_barrier(const XcdBarrier& b) {
    asm volatile("s_waitcnt vmcnt(0)" ::: "memory");
    __syncthreads();
    if (threadIdx.x == 0) {
        unsigned* bar = b.bar;
        __builtin_amdgcn_s_waitcnt(0);
        unsigned nloc = b.st[0], nx = b.st[1];
        if (nloc == 0u) { xcd_barrier_complete(bar, b.x, nloc, nx); b.st[0] = nloc; b.st[1] = nx; }
        const unsigned old = xb_add(&bar[XB_XSUB(b.x)], 1u);
        const unsigned gen = old / nloc;
        if (old + 1u == (gen + 1u) * nloc) {
            __builtin_amdgcn_fence(__ATOMIC_RELEASE, "agent");
            asm volatile("s_waitcnt vmcnt(0)" ::: "memory");
            const unsigned og = xb_add(&bar[XB_TOP], 1u);
            const unsigned tg = og / nx;
            if (og + 1u == (tg + 1u) * nx) xb_add(&bar[XB_TOPGEN], 1u);
            else XB_SPIN(xb_ld(&bar[XB_TOPGEN]) == tg, bar);
            __builtin_amdgcn_fence(__ATOMIC_ACQUIRE, "agent");
            xb_add(&bar[XB_XGEN(b.x)], 1u);
            asm volatile("s_waitcnt vmcnt(0)" ::: "memory");
        } else {
            XB_SPIN(xb_ld(&bar[XB_XGEN(b.x)]) == gen, bar);
            __builtin_amdgcn_fence(__ATOMIC_ACQUIRE, "agent");
            asm volatile("s_waitcnt vmcnt(0)" ::: "memory");
        }
    }
    __syncthreads();
}

constexpr int RSL_OFF = 131072, RSL_UNITS = 6;
template <bool BY_COL> __device__ __forceinline__ void stage_rstd(LAS unsigned char* lds, const pg8::StaticOrder& S, const i64* ssq) {
    LAS float* rsl = (LAS float*)(lds + RSL_OFF); const int tid = threadIdx.x;
#pragma unroll 1
    for (int i = 0; i < RSL_UNITS; ++i) { Unit u; if (!S.next(i, u)) break;
        if (tid < 256) rsl[i * 256 + tid] = __builtin_amdgcn_rsqf(fx_get(ssq + (BY_COL ? u.pn : u.pm) * 256 + tid) * (1.0f / DM) + EPS); }
    __syncthreads();
}

constexpr int PH_PER_LAYER = 7, N_PHASES = 1 + DEPTH * PH_PER_LAYER + 1;

__global__ void __launch_bounds__(NWAVES * 64, 2) fwd_kernel(Args a) {
    extern __shared__ __attribute__((aligned(16))) unsigned char lds_raw[];
    LAS unsigned char* lds = (LAS unsigned char*)lds_raw;
    const int G = gridDim.x, cu = blockIdx.x;
    const int lo = a.ph_lo, hi = a.ph_hi;
    const bool spread = (G == 256) && MK_ONE;
#define IDLE_CONVERT(slot) do { if (spread && cu >= 128) { __builtin_amdgcn_sched_barrier(0); int tid_ = threadIdx.x; asm volatile("" : "+v"(tid_) :: "memory"); const int wave_ = __builtin_amdgcn_readfirstlane(tid_ >> 6); \
        const int NW_ = 128 * NWAVES, w_ = (cu - 128) * NWAVES + wave_; \
        const int l1_ = l, lo1_ = (slot) == 0 ? 2 * I_GU : ((slot) == 1 ? I_LAYER - I_OUT : 2 * I_GU + I_D), n1_ = (slot) == 0 ? I_D : ((slot) == 1 ? I_OUT : I_D); \
        const int l2_ = (slot) == 2 ? l + 1 : l, lo2_ = (slot) == 0 ? 2 * I_GU + 2 * I_D : ((slot) == 1 ? I_GU : 0), n2_ = (slot) == 0 ? I_INN + I_INS : I_GU; \
        convert_weights(a, lds, l1_, lo1_, lo1_ + n1_, w_, NW_, wave_, tid_ & 63); \
        if (l2_ < DEPTH) convert_weights(a, lds, l2_, lo2_, lo2_ + n2_, (w_ + NW_ - (n1_ % NW_)) % NW_, NW_, wave_, tid_ & 63); \
        __syncthreads(); } } while (0)
#if MK_ONE
    cg::grid_group grid = cg::this_grid();
    { volatile LAS unsigned* misc = (volatile LAS unsigned*)(lds + MISC_OFF); if (threadIdx.x < 32) misc[threadIdx.x] = 0u; __syncthreads(); }
    XcdBarrier bar; bar.bar = (unsigned*)(as_global(a.ws) + WS_BAR); bar.x = xb_xcc_id(); bar.st = (volatile LAS unsigned*)(lds + MISC_OFF) + 8;
#define SEAM(k) do { if ((k) + 1 < hi) { if ((k) == 0) grid.sync(); else { xcd_barrier(bar); if (DUP & 4) xcd_barrier(bar); } } } while (0)
#else
#define SEAM(k) do { } while (0)
#endif
#define IN(k) (lo <= (k) && (k) < hi)
#define WSBASE() GAS unsigned char* wsg_ = (GAS unsigned char*)a.ws; asm volatile("" : "+s"(wsg_)); unsigned char* ws = (unsigned char*)wsg_; i64* stats = (i64*)(ws + WS_STATS); i64* st = stats + (size_t)(6 * l) * MTOK; unsigned char* wl = ws + WS_W + (size_t)l * WL_STRIDE; (void)st; (void)wl

    if (!(SKIP & 32) && IN(0)) {
        const int tid = threadIdx.x, lane = tid & 63, wave = __builtin_amdgcn_readfirstlane(tid >> 6);
        prologue(a, lds, cu * NWAVES + wave, G * NWAVES, wave, lane, spread ? -1 : DEPTH); __syncthreads();
        if (DUP & 8) { prologue(a, lds, cu * NWAVES + wave, G * NWAVES, wave, lane, spread ? -1 : DEPTH); __syncthreads(); }
#if MK_ONE
        if (cu == 0) { unsigned* bw = (unsigned*)(as_global(a.ws) + WS_BAR); for (int i = tid; i < (int)(BAR_BYTES / 4); i += NWAVES * 64) bw[i] = 0u; }
        grid.sync();
        if (tid == 0) (void)xb_add(&bar.bar[XB_XCNT(bar.x)], 1u);
#endif
    }

#pragma unroll 1
    for (int l = 0; l < DEPTH; ++l) {
        const int pb = 1 + l * PH_PER_LAYER;
#pragma unroll 1
        for (int f = 0; f < 2; ++f) {
            const int p0 = pb + (f ? 5 : 0);
            if (!(SKIP & 1) && IN(p0)) {
                WSBASE();
                pg8::Gemm g{(const bf16_t*)(ws + WS_XB), (const bf16_t*)(wl + (f ? WL_GU2 : WL_GU1)), MTOK, NGU, DM}; pg8::StaticOrder S; S.init(MTOK, NGU, G, cu);
                stage_rstd<false>(lds, S, st + (f ? 5 : 0) * MTOK);
                EpiSwiGLU E{(bf16_t*)(ws + WS_H), (const LAS float*)(lds + RSL_OFF)};
                pg8::gemm_phase<EpiSwiGLU, pg8::StaticOrder, true>(lds, g, S, E);
                if (DUP & 32) pg8::gemm_phase<EpiSwiGLU, pg8::StaticOrder, true>(lds, g, S, E);
                if (DUP & 256) { EpiNull EN; pg8::gemm_phase<EpiNull, pg8::StaticOrder, true>(lds, g, S, EN); }
                IDLE_CONVERT(f ? 2 : 0);
                SEAM(p0);
            }
            if (!(SKIP & 64) && IN(p0 + 1)) {
                WSBASE();
                pg8::Gemm g{(const bf16_t*)(ws + WS_H), (const bf16_t*)(wl + (f ? WL_D2 : WL_D1)), MTOK, DM, DFF}; pg8::StaticOrder S; S.init(MTOK, DM, G, cu);
                if (FUSE_FINAL && l == DEPTH - 1 && f == 1 && G == 256) {
                    EpiFinal E{as_global(a.out), as_global(a.out), st + 6 * MTOK, (unsigned*)(stats + (size_t)25 * MTOK), as_global(a.in[18]), 0.5f};
                    pg8::gemm_phase<EpiFinal, pg8::StaticOrder, true>(lds, g, S, E);
                } else {
                    EpiResid<-1> E{(l == 0 && f == 0) ? as_global(a.in[0]) : (const float*)as_global(a.out), as_global(a.out), (bf16_t*)(ws + WS_XB), st + (f ? 6 : 1) * MTOK, nullptr, 0.5f};
                    pg8::gemm_phase<EpiResid<-1>, pg8::StaticOrder, true>(lds, g, S, E);
                    SEAM(p0 + 1);
                }
            }
            if (f == 1) break;
            if (!(SKIP & 2) && IN(pb + 2)) {
                { WSBASE();
                  pg8::Gemm g{(const bf16_t*)(ws + WS_XB), (const bf16_t*)(wl + WL_INN), MTOK, 1536, DM}; pg8::StaticOrder S; S.init(MTOK, 1536, G, cu);
                  stage_rstd<false>(lds, S, st + 1 * MTOK);
                  EpiQKU E{(bf16_t*)(ws + WS_Q), (const LAS float*)(lds + RSL_OFF), (const float*)(ws + WS_ROT), (const float*)(ws + WS_ROT) + SEQ * 8};
                  pg8::gemm_phase<EpiQKU, pg8::StaticOrder, true>(lds, g, S, E);
                  if (DUP & 16) pg8::gemm_phase<EpiQKU, pg8::StaticOrder, true>(lds, g, S, E); }
                { WSBASE();
                  pg8::Gemm g{(const bf16_t*)(wl + WL_INS), (const bf16_t*)(ws + WS_XB), 1024, MTOK, DM}; pg8::StaticOrder S; S.init(1024, MTOK, G, G - 1 - cu);
                  stage_rstd<true>(lds, S, st + 1 * MTOK);
                  EpiVG E{(bf16_t*)(ws + WS_VT1), (bf16_t*)(ws + WS_VT4), (bf16_t*)(ws + WS_VT16), (bf16_t*)(ws + WS_GT), (const LAS float*)(lds + RSL_OFF), st + 3 * MTOK, st + 4 * MTOK};
                  pg8::gemm_phase<EpiVG, pg8::StaticOrder, true>(lds, g, S, E);
                  if (DUP & 16) { EpiVG E2 = E; E2.lnsum = stats + (size_t)30 * MTOK; E2.lnsq = stats + (size_t)31 * MTOK; pg8::gemm_phase<EpiVG, pg8::StaticOrder, true>(lds, g, S, E2); } }
                IDLE_CONVERT(1);
                SEAM(pb + 2);
            }
            if (IN(pb + 3)) {
                const int tid = threadIdx.x, lane = tid & 63, wave = __builtin_amdgcn_readfirstlane(tid >> 6);
                if (!(SKIP & 4)) { WSBASE();
                  for (int u = cu; u < 256; u += G) { const int j = u >> 3, bh = (u & 7) * 2 + (j >> 4), blk = j & 15;
                    attn_unit(lds, bh >> 3, bh & 7, blk, (const bf16_t*)(ws + WS_Q), (const bf16_t*)(ws + WS_K), (const bf16_t*)(ws + WS_VT1), (const bf16_t*)(ws + WS_VT4), (const bf16_t*)(ws + WS_VT16),
                              (bf16_t*)(ws + WS_MIX), st + 2 * MTOK, wave, lane);
                    if (DUP & 1) attn_unit(lds, bh >> 3, bh & 7, blk, (const bf16_t*)(ws + WS_Q), (const bf16_t*)(ws + WS_K), (const bf16_t*)(ws + WS_VT1), (const bf16_t*)(ws + WS_VT4), (const bf16_t*)(ws + WS_VT16),
                              (bf16_t*)(ws + WS_MIX), stats + (size_t)30 * MTOK, wave, lane); } }
                if (!(SKIP & 8)) { WSBASE();
                  for (int u = cu; u < MTOK / 128; u += G) for (int rp = 0; rp < ((DUP & 2) ? 2 : 1); ++rp)
                    sgu_unit(lds, u * 128, (const bf16_t*)(ws + WS_GT), (const bf16_t*)(ws + WS_U), (const bf16_t*)(ws + WS_SGUW) + (size_t)l * 4 * 16384, as_global(a.in[10]) + l * 512, as_global(a.in[7]) + l * DH, as_global(a.in[8]) + l * DH,
                             st + 3 * MTOK, st + 4 * MTOK, (bf16_t*)(ws + WS_MIX), wave, lane); }
                SEAM(pb + 3);
            }
            if (!(SKIP & 16) && IN(pb + 4)) {
                WSBASE();
                pg8::Gemm g{(const bf16_t*)(ws + WS_MIX), (const bf16_t*)(wl + WL_OUT), MTOK, DM, DM}; pg8::StaticOrder S; S.init(MTOK, DM, G, cu);
                EpiResid<8> E{as_global(a.out), as_global(a.out), (bf16_t*)(ws + WS_XB), st + 5 * MTOK, st + 2 * MTOK, 1.0f};
                pg8::gemm_phase<EpiResid<8>, pg8::StaticOrder, true>(lds, g, S, E);
                SEAM(pb + 4);
            }
        }
    }
    if (IN(N_PHASES - 1) && !(FUSE_FINAL && G == 256)) {
        const int tid = threadIdx.x, lane = tid & 63, wave = __builtin_amdgcn_readfirstlane(tid >> 6);
        const i64* fs = (const i64*)(as_global(a.ws) + WS_STATS) + (size_t)24 * MTOK; const f32x4* gn = (const f32x4*)as_global(a.in[18]) + lane;
        for (int m = cu * NWAVES + wave; m < MTOK; m += G * NWAVES) {
            const float rs = __builtin_amdgcn_rsqf(fx_get(fs + m) * (1.0f / DM) + EPS);
            f32x4* xr = (f32x4*)(as_global(a.out) + (size_t)m * DM) + lane;
            f32x4 xv[4];
#pragma unroll
            for (int j = 0; j < 4; ++j) xv[j] = xr[64 * j] * gn[64 * j];
#pragma unroll
            for (int j = 0; j < 4; ++j) xr[64 * j] = xv[j] * rs;
        }
    }
#undef IN
#undef SEAM
#undef WSBASE
#undef IDLE_CONVERT
}

extern "C" void kernel_launch(void* const* d_in, const int* in_sizes, int n_in, void* d_out, int out_size, void* d_ws, size_t ws_size, hipStream_t stream) {
    static int grid = 0;
    if (grid == 0) {
        if (n_in != 19 || out_size != MTOK * DM || ws_size < WS_END) { fprintf(stderr, "kernel_launch: unexpected shapes (n_in %d out %d ws %zu); nothing launched\n", n_in, out_size, ws_size); grid = -1; return; }
        int dev = 0, cus = 0, per_cu = 0;
        hipGetDevice(&dev); hipDeviceGetAttribute(&cus, hipDeviceAttributeMultiprocessorCount, dev);
        if (hipFuncSetAttribute((const void*)fwd_kernel, hipFuncAttributeMaxDynamicSharedMemorySize, LDS_BYTES) != hipSuccess) { fprintf(stderr, "kernel_launch: hipFuncSetAttribute failed\n"); grid = -1; return; }
        hipOccupancyMaxActiveBlocksPerMultiprocessor(&per_cu, (const void*)fwd_kernel, NWAVES * 64, LDS_BYTES);
        (void)hipGetLastError();
        if (per_cu < 1) fprintf(stderr, "kernel_launch: occupancy query says %d blocks per CU\n", per_cu);
        grid = cus > 0 ? cus : 256;
    }
    if (grid < 0) return;
    Args a{};
    for (int i = 0; i < 19; ++i) a.in[i] = (const float*)d_in[i];
    a.out = (float*)d_out; a.ws = (unsigned char*)d_ws;
#if MK_ONE
    a.ph_lo = 0; a.ph_hi = N_PHASES;
    void* args[] = {&a};
    hipError_t e = hipLaunchCooperativeKernel((const void*)fwd_kernel, dim3(grid), dim3(NWAVES * 64), args, LDS_BYTES, stream);
    if (e != hipSuccess) fprintf(stderr, "cooperative launch failed: %s (grid %d)\n", hipGetErrorString(e), grid);
#else
    for (int p = 0; p < N_PHASES; ++p) { a.ph_lo = p; a.ph_hi = p + 1; hipLaunchKernelGGL(fwd_kernel, dim3(grid), dim3(NWAVES * 64), LDS_BYTES, stream, a); }
#endif
}
```

```cpp
#include <hip/hip_runtime.h>
#include <hip/hip_cooperative_groups.h>
#include <cstdio>
#include <cstdint>
namespace cg = cooperative_groups;

#ifndef SKIP
#define SKIP 0
#endif
#ifndef DUP
#define DUP 0
#endif
#ifndef FUSE_FINAL
#define FUSE_FINAL 1
#endif
#ifndef MK_ONE
#define MK_ONE 1
#endif

namespace pg8 {
#define PG8_LAS __attribute__((address_space(3)))
typedef unsigned short bf16_t;
typedef short bf16x8 __attribute__((ext_vector_type(8)));
typedef float f32x4 __attribute__((ext_vector_type(4)));
typedef float f32x2 __attribute__((ext_vector_type(2)));
typedef unsigned u32x4 __attribute__((ext_vector_type(4)));
typedef unsigned u32x2 __attribute__((ext_vector_type(2)));
constexpr int BM = 256, BK = 64, HALF = 128, HTB = HALF * BK * 2, STAGE_BYTES = 8 * HTB, NXCD = 8, WGM = 8;

__host__ __device__ __forceinline__ int lds_byte(int r, int c) { const int st = (r >> 4) * 2 + (c >> 5), rr = r & 15, cc = c & 31, ob = rr * 64 + cc * 2; return st * 1024 + (ob ^ (((ob >> 9) & 1) << 5)); }
__host__ __device__ __forceinline__ void stage_rc(int b, int& R, int& C) { const int st = b / 1024, sb = b % 1024, swz = sb ^ (((sb >> 9) & 1) << 5); R = (st >> 1) * 16 + swz / 64; C = (st & 1) * 32 + (swz % 64) / 2; }
__host__ __device__ __forceinline__ int perm32(int rho) { const int n = rho >> 4, i = rho & 15; return 8 * (i >> 2) + 4 * n + (i & 3); }

struct Unit { int pm, pn; };
struct Gemm { const bf16_t* A; const bf16_t* Bt; int M, N, K; };

struct StaticOrder {
    int nM, nN, nwg, G, c;
    __host__ __device__ void init(int M, int N, int G_, int c_) { nM = M / BM; nN = N / BM; nwg = nM * nN; G = G_; c = c_; }
    __host__ __device__ bool next(int i, Unit& u) const {
        const long L = (long)i * G + c; if (L >= nwg) return false;
        int wgid = (int)L; { const int q = nwg / NXCD, r = nwg % NXCD, xcd = wgid % NXCD, off = wgid / NXCD; wgid = (xcd < r ? xcd * (q + 1) : r * (q + 1) + (xcd - r) * q) + off; }
        const int nig = WGM * nN, gid = wgid / nig, fm = gid * WGM, gsz = (nM - fm) < WGM ? (nM - fm) : WGM;
        u.pm = fm + ((wgid % nig) % gsz); u.pn = (wgid % nig) / gsz; return true;
    }
};

__device__ __forceinline__ unsigned cvt_pk_bf16(float lo, float hi) { unsigned r; asm volatile("v_cvt_pk_bf16_f32 %0, %1, %2" : "=v"(r) : "v"(lo), "v"(hi)); return r; }

__device__ __forceinline__ f32x2 gelu_pk(f32x2 v) {
    const f32x2 av = __builtin_elementwise_abs(v), d = av * 0.2316418882f + 1.0f;
    f32x2 t; t.x = __builtin_amdgcn_rcpf(d.x); t.y = __builtin_amdgcn_rcpf(d.y);
    f32x2 q = t * 0.5307027145f + (-0.7265760135f); q = q * t + 0.7107068705f; q = q * t + (-0.142248368f); q = q * t + 0.127414796f; q = q * t;
    const f32x2 s = (v * v) * (-0.72134752044f);
    f32x2 e; e.x = __builtin_amdgcn_exp2f(s.x); e.y = __builtin_amdgcn_exp2f(s.y);
    const f32x2 m = v * (q * e), r = v - m;
    f32x2 o; o.x = v.x < 0.f ? m.x : r.x; o.y = v.y < 0.f ? m.y : r.y; return o;
}
__device__ __forceinline__ f32x4 gelu4(f32x4 v) { f32x2 a = gelu_pk((f32x2){v[0], v[1]}), b = gelu_pk((f32x2){v[2], v[3]}); return (f32x4){a.x, a.y, b.x, b.y}; }

template <class Epi, class Sched, bool ALIGN_EPI = false>
__device__ __forceinline__ void gemm_phase(PG8_LAS unsigned char* lds, const Gemm g, const Sched& S, const Epi& E) {
    int tid_ = threadIdx.x; asm volatile("" : "+v"(tid_));
    const int tid = tid_, wid = __builtin_amdgcn_readfirstlane(tid >> 6), lane = tid & 63, wr = wid >> 2, wc = wid & 3, fr = lane & 15, fq = lane >> 4;
    const int K = g.K, nt = K / BK;
    unsigned voffA[2], voffB[2];
#pragma unroll
    for (int i = 0; i < 2; ++i) { int R, C; stage_rc(tid * 16 + i * 8192, R, C); const int Rb = Epi::PERM ? ((R & ~31) + perm32(R & 31)) : R;
        voffA[i] = (unsigned)(R * K + C) * 2u; voffB[i] = (unsigned)(Rb * K + C) * 2u; }
    const size_t kstep = (size_t)(BK * 2);
    const size_t hstep = (size_t)HALF * K * 2;
    const size_t tstep = 2 * hstep;
    const unsigned ldsw = (unsigned)wid * 1024u;
    const int aoff = lds_byte(wr * 64 + fr, fq * 8), boff = lds_byte(wc * 32 + fr, fq * 8);
#define PG8_SA(b, h) (((b) * 2 + (h)) * HTB)
#define PG8_SB(b, h) ((4 + (b) * 2 + (h)) * HTB)
#define PG8_STAGE(bufoff, gbase, voff) do { _Pragma("unroll") for (int _i = 0; _i < 2; ++_i) \
        __builtin_amdgcn_global_load_lds((const unsigned*)((const char*)(gbase) + (voff)[_i]), (PG8_LAS unsigned*)(lds + (bufoff) + ldsw + _i * 8192), 16, 0, 0); } while (0)
#define PG8_LDA(dst, b, h) do { _Pragma("unroll") for (int m = 0; m < 4; ++m) _Pragma("unroll") for (int k = 0; k < 2; ++k) dst[m][k] = *(const PG8_LAS bf16x8*)(lds + PG8_SA(b, h) + aoff + m * 2048 + k * 1024); } while (0)
#define PG8_LDB(dst, b, h) do { _Pragma("unroll") for (int n = 0; n < 2; ++n) _Pragma("unroll") for (int k = 0; k < 2; ++k) dst[n][k] = *(const PG8_LAS bf16x8*)(lds + PG8_SB(b, h) + boff + n * 2048 + k * 1024); } while (0)
#define PG8_MMA(ai, bj, At, Bt) do { __builtin_amdgcn_s_setprio(1); _Pragma("unroll") for (int m = 0; m < 4; ++m) _Pragma("unroll") for (int n = 0; n < 2; ++n) _Pragma("unroll") for (int k = 0; k < 2; ++k) \
        acc[ai][bj][m][n] = __builtin_amdgcn_mfma_f32_16x16x32_bf16(Bt[n][k], At[m][k], acc[ai][bj][m][n], 0, 0, 0); __builtin_amdgcn_s_setprio(0); } while (0)
#define PG8_WAIT_V(n) asm volatile("s_waitcnt vmcnt(" #n ")" ::: "memory")
#define PG8_WAIT_L(n) asm volatile("s_waitcnt lgkmcnt(" #n ")" ::: "memory")
#define PG8_BAR __builtin_amdgcn_s_barrier()
#define PG8_SCHED __builtin_amdgcn_sched_barrier(0)
    Unit cur, nxt; int ui = 0;
    if (!S.next(0, cur)) return;
    f32x4 acc[2][2][4][2];
#pragma unroll
    for (int a = 0; a < 2; ++a)
#pragma unroll
        for (int b = 0; b < 2; ++b)
#pragma unroll
            for (int m = 0; m < 4; ++m)
#pragma unroll
                for (int n = 0; n < 2; ++n) acc[a][b][m][n] = (f32x4){0.f, 0.f, 0.f, 0.f};
    bf16x8 At[4][2], B0[2][2], B1[2][2];
    const char* cA = (const char*)g.A + (size_t)cur.pm * tstep; const char* cB = (const char*)g.Bt + (size_t)cur.pn * tstep;
    {
        PG8_STAGE(PG8_SB(0, 0), cB, voffB); PG8_STAGE(PG8_SB(0, 1), cB + hstep, voffB); PG8_STAGE(PG8_SA(0, 0), cA, voffA); PG8_STAGE(PG8_SA(0, 1), cA + hstep, voffA);
        if (wr == 1) PG8_BAR;
        PG8_WAIT_V(2); PG8_BAR;
        PG8_STAGE(PG8_SB(1, 0), cB + kstep, voffB); PG8_STAGE(PG8_SA(1, 0), cA + kstep, voffA); PG8_STAGE(PG8_SB(1, 1), cB + hstep + kstep, voffB);
        PG8_WAIT_V(6); PG8_BAR;
    }
    for (;;) {
        const bool has_next = S.next(ui + 1, nxt);
        const char* nA = has_next ? (const char*)g.A + (size_t)nxt.pm * tstep : cA; const char* nB = has_next ? (const char*)g.Bt + (size_t)nxt.pn * tstep : cB;
        for (int t = 0; t < nt; t += 2) {
            const bool last = (t == nt - 2);
            const char* a1 = cA + (size_t)(t + 1) * kstep;
            const char* a2 = last ? nA : cA + (size_t)(t + 2) * kstep; const char* b2 = last ? nB : cB + (size_t)(t + 2) * kstep;
            const char* a3 = a2 + kstep; const char* b3 = b2 + kstep;
            if constexpr (Epi::MID_T > 0) { if (t == Epi::MID_T) E.mid(acc, cur, wr, fr); }
            PG8_LDB(B0, 0, 0); PG8_LDB(B1, 0, 1); PG8_SCHED; PG8_LDA(At, 0, 0); PG8_STAGE(PG8_SA(1, 1), a1 + hstep, voffA);
            PG8_WAIT_V(8); PG8_WAIT_L(0); PG8_BAR; PG8_MMA(0, 0, At, B0); PG8_MMA(0, 1, At, B1); PG8_BAR; PG8_SCHED;
            PG8_LDA(At, 0, 1); PG8_STAGE(PG8_SB(0, 0), b2, voffB); PG8_STAGE(PG8_SB(0, 1), b2 + hstep, voffB); PG8_STAGE(PG8_SA(0, 0), a2, voffA);
            PG8_WAIT_V(8); PG8_WAIT_L(0); PG8_BAR; PG8_MMA(1, 0, At, B0); PG8_MMA(1, 1, At, B1); PG8_BAR; PG8_SCHED;
            PG8_LDB(B0, 1, 0); PG8_LDB(B1, 1, 1); PG8_SCHED; PG8_LDA(At, 1, 0); PG8_STAGE(PG8_SA(0, 1), a2 + hstep, voffA);
            PG8_WAIT_V(8); PG8_WAIT_L(0); PG8_BAR; PG8_MMA(0, 0, At, B0); PG8_MMA(0, 1, At, B1); PG8_BAR; PG8_SCHED;
            PG8_LDA(At, 1, 1); PG8_STAGE(PG8_SB(1, 0), b3, voffB); PG8_STAGE(PG8_SB(1, 1), b3 + hstep, voffB); PG8_STAGE(PG8_SA(1, 0), a3, voffA);
            PG8_WAIT_V(8); PG8_WAIT_L(0); PG8_BAR; PG8_MMA(1, 0, At, B0); PG8_MMA(1, 1, At, B1); PG8_BAR; PG8_SCHED;
        }
        if constexpr (ALIGN_EPI) { if (wr == 0) PG8_BAR; }
        E(acc, cur, wr, wc, fr, fq, ui);
        if (!has_next) break;
#pragma unroll
        for (int a = 0; a < 2; ++a)
#pragma unroll
            for (int b = 0; b < 2; ++b)
#pragma unroll
                for (int m = 0; m < 4; ++m)
#pragma unroll
                    for (int n = 0; n < 2; ++n) acc[a][b][m][n] = (f32x4){0.f, 0.f, 0.f, 0.f};
        cur = nxt; cA = nA; cB = nB; ++ui;
        if constexpr (ALIGN_EPI) { if (wr == 1) PG8_BAR; }
    }
    PG8_WAIT_V(0);
    if constexpr (!ALIGN_EPI) { if (wr == 0) PG8_BAR; }
    PG8_BAR;
#undef PG8_SA
#undef PG8_SB
#undef PG8_STAGE
#undef PG8_LDA
#undef PG8_LDB
#undef PG8_MMA
#undef PG8_WAIT_V
#undef PG8_WAIT_L
#undef PG8_BAR
#undef PG8_SCHED
}
}

using pg8::bf16_t; using pg8::bf16x8; using pg8::f32x4; using pg8::f32x2; using pg8::u32x4; using pg8::u32x2; using pg8::Unit; using pg8::cvt_pk_bf16;
#define LAS __attribute__((address_space(3)))
#define GAS __attribute__((address_space(1)))
template <class T> __device__ __forceinline__ T* as_global(T* p) { return (T*)(GAS T*)p; }

constexpr int MTOK = 16384, DM = 1024, SEQ = 8192, DFF = 2816, NGU = 2 * DFF, DEPTH = 4, DH = 512;
constexpr float EPS = 1e-6f, LOG2E = 1.4426950408889634f;
constexpr int NWAVES = 8;
constexpr int LDS_BYTES = 147456;

constexpr size_t MiB = 1u << 20;
constexpr size_t WS_STATS = 0;
constexpr size_t WS_ROT = 340 * MiB;
constexpr size_t WS_SGUW = 341 * MiB;
constexpr size_t WS_W = 4 * MiB;
constexpr size_t WL_GU1 = 0, WL_D1 = 11 * MiB, WL_INN = WL_D1 + 5 * MiB + 512 * 1024, WL_INS = WL_INN + 3 * MiB, WL_OUT = WL_INS + 2 * MiB, WL_GU2 = WL_OUT + 2 * MiB, WL_D2 = WL_GU2 + 11 * MiB, WL_STRIDE = 40 * MiB;
static_assert(WL_D2 + 5 * MiB + 512 * 1024 == WL_STRIDE, "weight map");
constexpr size_t WS_XB = 164 * MiB;
constexpr size_t WS_H = 196 * MiB;
constexpr size_t WS_Q = 196 * MiB, WS_K = 212 * MiB, WS_U = 228 * MiB, WS_VT1 = 244 * MiB, WS_VT4 = 260 * MiB, WS_VT16 = 276 * MiB, WS_GT = 292 * MiB, WS_MIX = 308 * MiB, WS_BAR = 342 * MiB, WS_END = 343 * MiB;
constexpr size_t BAR_BYTES = 16384;
constexpr int MISC_OFF = 143424;
constexpr int NSLOT = 26;

typedef long long i64;
constexpr float FX = 16777216.0f, FXI = 1.0f / 16777216.0f;
__device__ __forceinline__ void fx_add(i64* p, float v) { atomicAdd((unsigned long long*)p, (unsigned long long)(i64)(v * FX)); }
__device__ __forceinline__ float fx_get(const i64* p) { return (float)(*p) * FXI; }

struct Args { const float* in[19]; float* out; unsigned char* ws; int ph_lo, ph_hi; };

__device__ __forceinline__ float silu_mul(float g, float u) { return g * __builtin_amdgcn_rcpf(1.0f + __builtin_amdgcn_exp2f(-g * LOG2E)) * u; }

struct EpiSwiGLU {
    static constexpr bool PERM = true; static constexpr int MID_T = -1;
    bf16_t* H; const LAS float* rsl;
    __device__ __forceinline__ void mid(f32x4 (&)[2][2][4][2], const Unit&, int, int) const {}
    __device__ __forceinline__ void operator()(const f32x4 (&acc)[2][2][4][2], const Unit& u, int wr, int wc, int fr, int fq, int ui) const {
        const int row0 = u.pm * 256 + wr * 64 + fr, hc = u.pn * 128 + wc * 32 + 8 * fq;
#pragma unroll
        for (int ai = 0; ai < 2; ++ai)
#pragma unroll
            for (int m = 0; m < 4; ++m) {
                const int r = row0 + ai * 128 + m * 16; const float rs = rsl[ui * 256 + wr * 64 + fr + ai * 128 + m * 16];
                const f32x4 g0 = acc[ai][0][m][0] * rs, g1 = acc[ai][0][m][1] * rs, u0 = acc[ai][1][m][0] * rs, u1 = acc[ai][1][m][1] * rs;
                u32x4 w;
                w.x = cvt_pk_bf16(silu_mul(g0[0], u0[0]), silu_mul(g0[1], u0[1])); w.y = cvt_pk_bf16(silu_mul(g0[2], u0[2]), silu_mul(g0[3], u0[3]));
                w.z = cvt_pk_bf16(silu_mul(g1[0], u1[0]), silu_mul(g1[1], u1[1])); w.w = cvt_pk_bf16(silu_mul(g1[2], u1[2]), silu_mul(g1[3], u1[3]));
                *(u32x4*)(H + (size_t)r * DFF + hc) = w;
            }
    }
};

struct EpiNull {
    static constexpr bool PERM = true; static constexpr int MID_T = -1;
    __device__ __forceinline__ void mid(f32x4 (&)[2][2][4][2], const Unit&, int, int) const {}
    __device__ __forceinline__ void operator()(const f32x4 (&acc)[2][2][4][2], const Unit& u, int wr, int wc, int fr, int fq, int ui) const {
#pragma unroll
        for (int ai = 0; ai < 2; ++ai)
#pragma unroll
            for (int bj = 0; bj < 2; ++bj)
#pragma unroll
                for (int m = 0; m < 4; ++m) { asm volatile("" :: "v"(acc[ai][bj][m][0]), "v"(acc[ai][bj][m][1])); }
    }
};

template <int MIDT> struct EpiResid {
    static constexpr bool PERM = true; static constexpr int MID_T = MIDT;
    const float* Xin; float* X; bf16_t* XB; i64* ssq_out; const i64* mid_ssq; float alpha;
    __device__ __forceinline__ void mid(f32x4 (&acc)[2][2][4][2], const Unit& u, int wr, int fr) const {
        const int row0 = u.pm * 256 + wr * 64 + fr;
        i64 q[2][4];
#pragma unroll
        for (int ai = 0; ai < 2; ++ai)
#pragma unroll
            for (int m = 0; m < 4; ++m) q[ai][m] = mid_ssq[row0 + ai * 128 + m * 16];
#pragma unroll
        for (int ai = 0; ai < 2; ++ai)
#pragma unroll
            for (int m = 0; m < 4; ++m) { const float rs = __builtin_amdgcn_rsqf((float)q[ai][m] * FXI * (1.0f / DH) + EPS);
#pragma unroll
                for (int bj = 0; bj < 2; ++bj) { acc[ai][bj][m][0] = acc[ai][bj][m][0] * rs; acc[ai][bj][m][1] = acc[ai][bj][m][1] * rs; } }
    }
    __device__ __forceinline__ void operator()(const f32x4 (&acc)[2][2][4][2], const Unit& u, int wr, int wc, int fr, int fq, int ui) const {
        const int row0 = u.pm * 256 + wr * 64 + fr, col0 = u.pn * 256 + wc * 32 + 8 * fq;
#pragma unroll
        for (int ai = 0; ai < 2; ++ai) {
            f32x4 xv[4][2][2];
#pragma unroll
            for (int m = 0; m < 4; ++m)
#pragma unroll
                for (int bj = 0; bj < 2; ++bj) { const float* xp = Xin + (size_t)(row0 + ai * 128 + m * 16) * DM + col0 + bj * 128; xv[m][bj][0] = *(const f32x4*)xp; xv[m][bj][1] = *(const f32x4*)(xp + 4); }
            __builtin_amdgcn_sched_barrier(0);
#pragma unroll
            for (int m = 0; m < 4; ++m) {
                const int r = row0 + ai * 128 + m * 16; float part = 0.f;
#pragma unroll
                for (int bj = 0; bj < 2; ++bj) {
                    float* xp = X + (size_t)r * DM + col0 + bj * 128;
                    const f32x4 x0 = xv[m][bj][0] + acc[ai][bj][m][0] * alpha, x1 = xv[m][bj][1] + acc[ai][bj][m][1] * alpha;
                    *(f32x4*)xp = x0; *(f32x4*)(xp + 4) = x1;
                    part += (x0[0] * x0[0] + x0[1] * x0[1]) + (x0[2] * x0[2] + x0[3] * x0[3]) + (x1[0] * x1[0] + x1[1] * x1[1]) + (x1[2] * x1[2] + x1[3] * x1[3]);
                    u32x4 w; w.x = cvt_pk_bf16(x0[0], x0[1]); w.y = cvt_pk_bf16(x0[2], x0[3]); w.z = cvt_pk_bf16(x1[0], x1[1]); w.w = cvt_pk_bf16(x1[2], x1[3]);
                    *(u32x4*)(XB + (size_t)r * DM + col0 + bj * 128) = w;
                }
                part += __shfl_xor(part, 16); part += __shfl_xor(part, 32);
                if (fq == 0) fx_add(ssq_out + r, part);
            }
            __builtin_amdgcn_sched_barrier(0);
        }
    }
};

struct EpiFinal {
    static constexpr bool PERM = true; static constexpr int MID_T = -1;
    const float* Xin; float* Out; i64* ssq; unsigned* cnt; const float* gain; float alpha;
    __device__ __forceinline__ void mid(f32x4 (&)[2][2][4][2], const Unit&, int, int) const {}
    __device__ __forceinline__ void operator()(f32x4 (&acc)[2][2][4][2], const Unit& u, int wr, int wc, int fr, int fq, int ui) const {
        const int row0 = u.pm * 256 + wr * 64 + fr, col0 = u.pn * 256 + wc * 32 + 8 * fq;
#pragma unroll
        for (int ai = 0; ai < 2; ++ai) {
            f32x4 xv[4][2][2];
#pragma unroll
            for (int m = 0; m < 4; ++m)
#pragma unroll
                for (int bj = 0; bj < 2; ++bj) { const float* xp = Xin + (size_t)(row0 + ai * 128 + m * 16) * DM + col0 + bj * 128; xv[m][bj][0] = *(const f32x4*)xp; xv[m][bj][1] = *(const f32x4*)(xp + 4); }
            __builtin_amdgcn_sched_barrier(0);
#pragma unroll
            for (int m = 0; m < 4; ++m) {
                float part = 0.f;
#pragma unroll
                for (int bj = 0; bj < 2; ++bj) {
                    const f32x4 x0 = xv[m][bj][0] + acc[ai][bj][m][0] * alpha, x1 = xv[m][bj][1] + acc[ai][bj][m][1] * alpha;
                    acc[ai][bj][m][0] = x0; acc[ai][bj][m][1] = x1;
                    part += (x0[0] * x0[0] + x0[1] * x0[1]) + (x0[2] * x0[2] + x0[3] * x0[3]) + (x1[0] * x1[0] + x1[1] * x1[1]) + (x1[2] * x1[2] + x1[3] * x1[3]);
                }
                part += __shfl_xor(part, 16); part += __shfl_xor(part, 32);
                if (fq == 0) fx_add(ssq + row0 + ai * 128 + m * 16, part);
            }
        }
        asm volatile("s_waitcnt vmcnt(0)" ::: "memory");
        unsigned* cw = cnt + 64 * u.pm;
        if ((threadIdx.x & 63) == 0) __hip_atomic_fetch_add(cw, 1u, __ATOMIC_RELAXED, __HIP_MEMORY_SCOPE_AGENT);
        { unsigned sp = 0;
          while ((unsigned)__builtin_amdgcn_readfirstlane(__hip_atomic_load(cw, __ATOMIC_RELAXED, __HIP_MEMORY_SCOPE_AGENT)) < 32u) { __builtin_amdgcn_s_sleep(2); if (++sp > (1u << 20)) break; } }
        f32x4 gv[2][2];
#pragma unroll
        for (int bj = 0; bj < 2; ++bj) { gv[bj][0] = *(const f32x4*)(gain + col0 + bj * 128); gv[bj][1] = *(const f32x4*)(gain + col0 + bj * 128 + 4); }
        i64 q[2][4];
#pragma unroll
        for (int ai = 0; ai < 2; ++ai)
#pragma unroll
            for (int m = 0; m < 4; ++m) q[ai][m] = (i64)__hip_atomic_load((unsigned long long*)(ssq + row0 + ai * 128 + m * 16), __ATOMIC_RELAXED, __HIP_MEMORY_SCOPE_AGENT);
#pragma unroll
        for (int ai = 0; ai < 2; ++ai)
#pragma unroll
            for (int m = 0; m < 4; ++m) {
                const float rs = __builtin_amdgcn_rsqf((float)q[ai][m] * FXI * (1.0f / DM) + EPS);
                float* op = Out + (size_t)(row0 + ai * 128 + m * 16) * DM + col0;
#pragma unroll
                for (int bj = 0; bj < 2; ++bj) { *(f32x4*)(op + bj * 128) = acc[ai][bj][m][0] * rs * gv[bj][0]; *(f32x4*)(op + bj * 128 + 4) = acc[ai][bj][m][1] * rs * gv[bj][1]; }
            }
    }
};

struct EpiQKU {
    static constexpr bool PERM = true; static constexpr int MID_T = -1;
    bf16_t *Q; const LAS float* rsl; const float* rcos; const float* rsin;
    __device__ __forceinline__ void mid(f32x4 (&)[2][2][4][2], const Unit&, int, int) const {}
    __device__ __forceinline__ void operator()(const f32x4 (&acc)[2][2][4][2], const Unit& u, int wr, int wc, int fr, int fq, int ui) const {
        const int sect = u.pn >> 1; bf16_t* base = Q + (size_t)sect * 8388608;
        const int row0 = u.pm * 256 + wr * 64 + fr, colt = (u.pn & 1) * 256 + wc * 32 + 8 * fq;
        const bool rot = (sect < 2) && ((wc & 1) == 0);
        const float sgn = (fq == 0) ? -1.f : 1.f; const float osc = (sect == 0) ? 0.125f * LOG2E : 1.f;
#pragma unroll
        for (int ai = 0; ai < 2; ++ai)
#pragma unroll
            for (int m = 0; m < 4; ++m) {
                const int r = row0 + ai * 128 + m * 16; const float rs = rsl[ui * 256 + wr * 64 + fr + ai * 128 + m * 16];
                const int pos = r & (SEQ - 1);
                f32x4 c0, c1, s0, s1;
                if (rot) { c0 = *(const f32x4*)(rcos + pos * 8); c1 = *(const f32x4*)(rcos + pos * 8 + 4); s0 = *(const f32x4*)(rsin + pos * 8); s1 = *(const f32x4*)(rsin + pos * 8 + 4); }
#pragma unroll
                for (int bj = 0; bj < 2; ++bj) {
                    f32x4 v0 = acc[ai][bj][m][0] * rs, v1 = acc[ai][bj][m][1] * rs;
                    if (sect == 2) { v0 = pg8::gelu4(v0); v1 = pg8::gelu4(v1); }
                    else {
                        if (rot) {
                            f32x4 p0, p1;
#pragma unroll
                            for (int i = 0; i < 4; ++i) { p0[i] = __shfl_xor(v0[i], 16); p1[i] = __shfl_xor(v1[i], 16); }
                            if (fq < 2) { v0 = v0 * c0 + p0 * s0 * sgn; v1 = v1 * c1 + p1 * s1 * sgn; }
                        }
                        v0 = v0 * osc; v1 = v1 * osc;
                    }
                    u32x4 w; w.x = cvt_pk_bf16(v0[0], v0[1]); w.y = cvt_pk_bf16(v0[2], v0[3]); w.z = cvt_pk_bf16(v1[0], v1[1]); w.w = cvt_pk_bf16(v1[2], v1[3]);
                    const int cc = colt + bj * 128;
                    if (sect == 2) *(u32x4*)(base + (size_t)r * DH + cc) = w;
                    else *(u32x4*)(base + ((size_t)((r >> 13) * 8 + (cc >> 6)) * SEQ + (r & (SEQ - 1))) * 64 + (cc & 63)) = w;
                }
            }
    }
};

struct EpiVG {
    static constexpr bool PERM = true; static constexpr int MID_T = -1;
    bf16_t *Vt1, *Vt4, *Vt16, *Gt; const LAS float* rsl; i64* lnsum; i64* lnsq;
    __device__ __forceinline__ void mid(f32x4 (&)[2][2][4][2], const Unit&, int, int) const {}
    __device__ __forceinline__ void operator()(const f32x4 (&acc)[2][2][4][2], const Unit& u, int wr, int wc, int fr, int fq, int ui) const {
        const int sect = u.pm >> 1;
        const int ch0 = (u.pm & 1) * 256 + wr * 64 + fr;
#pragma unroll
        for (int bj = 0; bj < 2; ++bj) {
            const int tok = u.pn * 256 + wc * 32 + 8 * fq + bj * 128;
            const LAS float* rp = rsl + ui * 256 + wc * 32 + 8 * fq + bj * 128;
            const f32x4 rs0 = *(const LAS f32x4*)rp, rs1 = *(const LAS f32x4*)(rp + 4);
            if (sect == 0) {
                const int b_ = tok >> 13, t0 = tok & (SEQ - 1);
#pragma unroll
                for (int ai = 0; ai < 2; ++ai)
#pragma unroll
                    for (int m = 0; m < 4; ++m) {
                        const int ch = ch0 + ai * 128 + m * 16;
                        const size_t bhb = (size_t)(b_ * 8 + (ch >> 6)) * (SEQ * 64) + (size_t)(ch & 63) * 8;
                        const f32x4 v0 = acc[ai][bj][m][0] * rs0, v1 = acc[ai][bj][m][1] * rs1;
                        u32x4 w; w.x = cvt_pk_bf16(v0[0], v0[1]); w.y = cvt_pk_bf16(v0[2], v0[3]); w.z = cvt_pk_bf16(v1[0], v1[1]); w.w = cvt_pk_bf16(v1[2], v1[3]);
                        *(u32x4*)(Vt1 + bhb + (size_t)(t0 >> 3) * 512) = w;
                        { const unsigned a0 = cvt_pk_bf16(v0[0], v1[0]), a1 = cvt_pk_bf16(v0[1], v1[1]), a2 = cvt_pk_bf16(v0[2], v1[2]), a3 = cvt_pk_bf16(v0[3], v1[3]);
                          const bool odd = fq & 1;
                          const unsigned s0 = odd ? a0 : a2, s1 = odd ? a1 : a3;
                          const unsigned r0 = (unsigned)__shfl_xor((int)s0, 16), r1 = (unsigned)__shfl_xor((int)s1, 16);
                          const int n = (t0 & ~15) >> 2, rb = odd ? 2 : 0;
                          bf16_t* p4 = Vt4 + bhb + (size_t)(rb * 256 + (n >> 3)) * 512 + (n & 7);
                          u32x2 q0, q1; q0.x = odd ? r0 : a0; q0.y = odd ? a2 : r0; q1.x = odd ? r1 : a1; q1.y = odd ? a3 : r1;
                          *(u32x2*)p4 = q0; *(u32x2*)(p4 + (size_t)256 * 512) = q1; }
                        { const bool hi = fq & 2;
                          const unsigned s0 = hi ? w.x : w.z, s1 = hi ? w.y : w.w;
                          const unsigned r0 = (unsigned)__shfl_xor((int)s0, 32), r1 = (unsigned)__shfl_xor((int)s1, 32);
                          const unsigned lo0 = hi ? r0 : w.x, lo1 = hi ? r1 : w.y, hi0 = hi ? w.z : r0, hi1 = hi ? w.w : r1;
                          const int n = (t0 & ~31) >> 4, rb = (t0 & 8) + (hi ? 4 : 0);
                          bf16_t* p16 = Vt16 + bhb + (size_t)(rb * 64 + (n >> 3)) * 512 + (n & 7);
                          *(unsigned*)(p16 + (size_t)0 * 64 * 512) = (lo0 & 0xffffu) | (hi0 << 16);
                          *(unsigned*)(p16 + (size_t)1 * 64 * 512) = (lo0 >> 16) | (hi0 & 0xffff0000u);
                          *(unsigned*)(p16 + (size_t)2 * 64 * 512) = (lo1 & 0xffffu) | (hi1 << 16);
                          *(unsigned*)(p16 + (size_t)3 * 64 * 512) = (lo1 >> 16) | (hi1 & 0xffff0000u); }
                    }
            } else {
                f32x4 sm0 = (f32x4){0.f, 0.f, 0.f, 0.f}, sm1 = sm0, sq0 = sm0, sq1 = sm0;
#pragma unroll
                for (int ai = 0; ai < 2; ++ai)
#pragma unroll
                    for (int m = 0; m < 4; ++m) {
                        const int ch = ch0 + ai * 128 + m * 16;
                        const f32x4 v0 = pg8::gelu4(acc[ai][bj][m][0] * rs0), v1 = pg8::gelu4(acc[ai][bj][m][1] * rs1);
                        sm0 = sm0 + v0; sm1 = sm1 + v1; sq0 = sq0 + v0 * v0; sq1 = sq1 + v1 * v1;
                        u32x4 w; w.x = cvt_pk_bf16(v0[0], v0[1]); w.y = cvt_pk_bf16(v0[2], v0[3]); w.z = cvt_pk_bf16(v1[0], v1[1]); w.w = cvt_pk_bf16(v1[2], v1[3]);
                        *(u32x4*)(Gt + ((size_t)(tok >> 3) * 512 + ch) * 8) = w;
                    }
#pragma unroll
                for (int i = 0; i < 4; ++i) {
                    float a0 = sm0[i], a1 = sm1[i], b0 = sq0[i], b1 = sq1[i];
#pragma unroll
                    for (int o = 1; o < 16; o <<= 1) { a0 += __shfl_xor(a0, o); a1 += __shfl_xor(a1, o); b0 += __shfl_xor(b0, o); b1 += __shfl_xor(b1, o); }
                    if (fr == 0) { fx_add(lnsum + tok + i, a0); fx_add(lnsum + tok + 4 + i, a1); fx_add(lnsq + tok + i, b0); fx_add(lnsq + tok + 4 + i, b1); }
                }
            }
        }
    }
};

__device__ __forceinline__ float wave_sum(float v) {
#pragma unroll
    for (int o = 1; o < 64; o <<= 1) v += __shfl_xor(v, o);
    return v;
}
struct ConvItem { const float* src; const float* gain; bf16_t* dst; int Nsrc, K; };
constexpr int I_GU = 16 * (NGU / 64), I_D = (DFF / 64) * 16, I_INN = 16 * 24, I_INS = 16 * 16, I_OUT = 16 * 16;
constexpr int I_LAYER = 2 * I_GU + 2 * I_D + I_INN + I_INS + I_OUT;
__device__ __forceinline__ ConvItem conv_decode(const Args& a, int l, int it) {
    unsigned char* wl = as_global(a.ws) + WS_W + (size_t)l * WL_STRIDE;
    ConvItem c; int r = it;
    if (r < 2 * I_GU) {
        const int f = r / I_GU; r %= I_GU;
        const int kb = r / (NGU / 64), nb = r % (NGU / 64), n0d = 64 * nb, hb = n0d >> 7;
        const float* src = (hb & 1) ? as_global(a.in[f ? 16 : 3]) : as_global(a.in[f ? 15 : 2]);
        c.src = src + (size_t)l * DM * DFF + (size_t)(64 * kb) * DFF + (hb >> 1) * 128 + (n0d & 127); c.Nsrc = DFF; c.K = DM;
        c.gain = as_global(a.in[f ? 14 : 1]) + l * DM + 64 * kb; c.dst = (bf16_t*)(wl + (f ? WL_GU2 : WL_GU1)) + (size_t)n0d * DM + 64 * kb; return c;
    }
    r -= 2 * I_GU;
    if (r < 2 * I_D) {
        const int f = r / I_D; r %= I_D;
        const int kb = r / 16, nb = r % 16;
        c.src = as_global(a.in[f ? 17 : 4]) + (size_t)l * DFF * DM + (size_t)(64 * kb) * DM + 64 * nb; c.Nsrc = DM; c.K = DFF; c.gain = nullptr;
        c.dst = (bf16_t*)(wl + (f ? WL_D2 : WL_D1)) + (size_t)(64 * nb) * DFF + 64 * kb; return c;
    }
    r -= 2 * I_D;
    if (r < I_INN) {
        const int kb = r / 24, nb = r % 24, n0d = 64 * nb;
        c.src = as_global(a.in[6]) + (size_t)l * DM * 2560 + (size_t)(64 * kb) * 2560 + (n0d < 1024 ? n0d : n0d + 512); c.Nsrc = 2560; c.K = DM;
        c.gain = as_global(a.in[5]) + l * DM + 64 * kb; c.dst = (bf16_t*)(wl + WL_INN) + (size_t)n0d * DM + 64 * kb; return c;
    }
    r -= I_INN;
    if (r < I_INS) {
        const int kb = r / 16, nb = r % 16, n0d = 64 * nb;
        c.src = as_global(a.in[6]) + (size_t)l * DM * 2560 + (size_t)(64 * kb) * 2560 + (n0d < 512 ? 1024 + n0d : 1536 + n0d); c.Nsrc = 2560; c.K = DM;
        c.gain = as_global(a.in[5]) + l * DM + 64 * kb; c.dst = (bf16_t*)(wl + WL_INS) + (size_t)n0d * DM + 64 * kb; return c;
    }
    r -= I_INS;
    {
        const int kb = r / 16, nb = r % 16, k0 = 64 * kb;
        c.src = as_global(a.in[13]) + (size_t)l * DM * DM + (size_t)k0 * DM + 64 * nb; c.Nsrc = DM; c.K = DM;
        c.gain = k0 < 512 ? as_global(a.in[11]) + l * DH + k0 : as_global(a.in[12]) + l * DH + (k0 - 512);
        c.dst = (bf16_t*)(wl + WL_OUT) + (size_t)(64 * nb) * DM + k0; return c;
    }
}
__device__ __forceinline__ void conv_issue(const ConvItem& c, f32x4 (&v)[16], float (&gs)[16], int lane) {
#pragma unroll
    for (int i = 0; i < 16; ++i) { const int kk = 4 * i + (lane >> 4); v[i] = __builtin_nontemporal_load((const f32x4*)(c.src + (size_t)kk * c.Nsrc + 4 * (lane & 15))); gs[i] = c.gain ? c.gain[kk] : 1.0f; }
}
__device__ __forceinline__ void conv_finish(const ConvItem& c, const f32x4 (&v)[16], const float (&gs)[16], LAS float* scr, int lane) {
#pragma unroll
    for (int i = 0; i < 16; ++i) { const int kk = 4 * i + (lane >> 4); LAS float* d = scr + kk * 65 + 4 * (lane & 15);
        d[0] = v[i][0] * gs[i]; d[1] = v[i][1] * gs[i]; d[2] = v[i][2] * gs[i]; d[3] = v[i][3] * gs[i]; }
    asm volatile("s_waitcnt lgkmcnt(0)" ::: "memory");
    const int cc = lane & 7;
#pragma unroll
    for (int j = 0; j < 8; ++j) { const int n = (lane >> 3) + 8 * j; const LAS float* sp = scr + (8 * cc) * 65 + n;
        u32x4 o; o.x = cvt_pk_bf16(sp[0 * 65], sp[1 * 65]); o.y = cvt_pk_bf16(sp[2 * 65], sp[3 * 65]); o.z = cvt_pk_bf16(sp[4 * 65], sp[5 * 65]); o.w = cvt_pk_bf16(sp[6 * 65], sp[7 * 65]);
        *(u32x4*)(c.dst + (size_t)n * c.K + 8 * cc) = o; }
    asm volatile("s_waitcnt lgkmcnt(0)" ::: "memory");
}
__device__ __forceinline__ void convert_weights(const Args& a, LAS unsigned char* lds, int l, int it_lo, int it_hi, int w, int NW, int wave, int lane) {
    LAS float* scr = (LAS float*)(lds + wave * 16640);
    int it = it_lo + w; if (it >= it_hi) return;
    ConvItem cur = conv_decode(a, l, it); f32x4 v[16]; float gs[16];
    conv_issue(cur, v, gs, lane);
#pragma unroll 1
    for (;;) {
        const int nx = it + NW; const bool more = nx < it_hi;
        ConvItem nxt = cur; f32x4 v2[16]; float gs2[16];
        if (more) { nxt = conv_decode(a, l, nx); conv_issue(nxt, v2, gs2, lane); }
        __builtin_amdgcn_sched_barrier(0);
        conv_finish(cur, v, gs, scr, lane);
        if (!more) break;
        cur = nxt; it = nx;
#pragma unroll
        for (int i = 0; i < 16; ++i) { v[i] = v2[i]; gs[i] = gs2[i]; }
    }
}

__device__ __forceinline__ void prologue(const Args& a, LAS unsigned char* lds, int gw, int NGW, int wave, int lane, int nlayers) {
    unsigned char* ws = as_global(a.ws);
    float* outp = as_global(a.out);
    if (nlayers < 0) convert_weights(a, lds, 0, 0, I_GU, gw, NGW, wave, lane);
    else
#pragma unroll 1
    for (int l = 0; l < nlayers; ++l) convert_weights(a, lds, l, 0, I_LAYER, gw, NGW, wave, lane);
    i64* stats = (i64*)(ws + WS_STATS);
    for (int m = gw; m < MTOK; m += NGW) {
        const f32x4* xr = (const f32x4*)(as_global(a.in[0]) + (size_t)m * DM) + lane;
        u32x2* xb = (u32x2*)((bf16_t*)(ws + WS_XB) + (size_t)m * DM) + lane;
        float s = 0.f; f32x4 xin[4];
#pragma unroll
        for (int j = 0; j < 4; ++j) xin[j] = xr[64 * j];
#pragma unroll
        for (int j = 0; j < 4; ++j) { const f32x4 v = xin[j]; s += (v[0] * v[0] + v[1] * v[1]) + (v[2] * v[2] + v[3] * v[3]);
            u32x2 w; w.x = cvt_pk_bf16(v[0], v[1]); w.y = cvt_pk_bf16(v[2], v[3]); xb[64 * j] = w; }
        s = wave_sum(s);
        if (lane == 0) stats[m] = (i64)(s * FX);
    }
    { const int gt = gw * 64 + lane, NGT = NGW * 64;
      for (int i = gt; i < (NSLOT - 1) * MTOK / 2; i += NGT) ((f32x4*)(stats + MTOK))[i] = (f32x4){0.f, 0.f, 0.f, 0.f};
      float* rc = (float*)(ws + WS_ROT); float* rsn = rc + SEQ * 8;
      for (int i = gt; i < SEQ * 8; i += NGT) { const int pos = i >> 3, j = i & 7;
          const float inv = exp2f(-(float)j * 2.36644607116552f);
          const float ang = (float)pos * inv;
          const double rev = (double)ang * 0.15915494309189535; const float fr_ = (float)(rev - floor(rev));
          rc[i] = __builtin_amdgcn_cosf(fr_); rsn[i] = __builtin_amdgcn_sinf(fr_); }
      bf16_t* sw = (bf16_t*)(ws + WS_SGUW);
      for (int i = gt; i < DEPTH * 4 * 128 * 128 / 4; i += NGT) { const f32x4 v = ((const f32x4*)as_global(a.in[9]))[i]; u32x2 w; w.x = cvt_pk_bf16(v[0], v[1]); w.y = cvt_pk_bf16(v[2], v[3]); ((u32x2*)sw)[i] = w; }
    }
}

constexpr int OP = 68;
constexpr int ABLK = 512;
__device__ __forceinline__ void attn_unit(LAS unsigned char* lds, int b, int h, int blk, const bf16_t* Q, const bf16_t* Kb, const bf16_t* Vt1, const bf16_t* Vt4, const bf16_t* Vt16,
                                          bf16_t* MIX, i64* ssq_a, int wid, int lane_in) {
    int lane = lane_in; asm volatile("" : "+v"(lane));
    LAS float* Oacc = (LAS float*)lds; LAS float* Ml = Oacc + ABLK * OP;
    const int qi = lane & 15, kq = lane >> 4, T0 = blk * ABLK;
    const size_t tb = (size_t)b * SEQ; const size_t bhb = (size_t)(b * 8 + h) * (SEQ * 64);
#pragma unroll 1
    for (int p = 0; p < 3; ++p) {
        const int lg = 2 * p, L = SEQ >> lg;
        const bf16_t* Vt = p == 0 ? Vt1 : (p == 1 ? Vt4 : Vt16);
#pragma unroll 1
        for (int it = 0; it < 2; ++it) {
            const int pi = wid * 2 + it;
            int r, n0;
            if (p == 0) { r = 0; n0 = T0 + 32 * pi; } else if (p == 1) { r = pi >> 2; n0 = (T0 >> 2) + 32 * (pi & 3); } else { r = pi; n0 = T0 >> 4; }
            const int ws_ = n0 - 64;
            int qtok[2]; bf16x8 qf[2][2];
#pragma unroll
            for (int g = 0; g < 2; ++g) { qtok[g] = ((n0 + 16 * g + qi) << lg) + r; const bf16_t* qp = Q + bhb + (size_t)qtok[g] * 64 + kq * 16; qf[g][0] = *(const bf16x8*)qp; qf[g][1] = *(const bf16x8*)(qp + 8); }
            bf16x8 kf[10][2];
#pragma unroll
            for (int t = 0; t < 10; ++t) {
                const int widx = 32 * (t >> 1) + 8 * (qi >> 2) + 4 * (t & 1) + (qi & 3);
                int kn = ws_ + widx; kn = kn < 0 ? 0 : (kn > L - 1 ? L - 1 : kn);
                const bf16_t* kp = Kb + bhb + (size_t)((kn << lg) + r) * 64 + kq * 16;
                kf[t][0] = *(const bf16x8*)kp; kf[t][1] = *(const bf16x8*)(kp + 8);
            }
            __builtin_amdgcn_sched_barrier(0);
            f32x4 s[2][10];
#pragma unroll
            for (int t = 0; t < 10; ++t)
#pragma unroll
                for (int g = 0; g < 2; ++g) {
                    f32x4 z = (f32x4){0.f, 0.f, 0.f, 0.f};
                    z = __builtin_amdgcn_mfma_f32_16x16x32_bf16(kf[t][0], qf[g][0], z, 0, 0, 0);
                    z = __builtin_amdgcn_mfma_f32_16x16x32_bf16(kf[t][1], qf[g][1], z, 0, 0, 0);
                    s[g][t] = z;
                }
            __builtin_amdgcn_sched_barrier(0);
            bf16x8 vf[5][4];
#pragma unroll
            for (int c = 0; c < 5; ++c) {
                int gk = ws_ + 32 * c + 8 * kq; gk = (gk < 0 || gk >= L) ? 0 : gk;
                const bf16_t* vp = Vt + bhb + ((size_t)(r * (L >> 3) + (gk >> 3)) * 64 + qi) * 8;
#pragma unroll
                for (int dt = 0; dt < 4; ++dt) vf[c][dt] = *(const bf16x8*)(vp + dt * 128);
            }
            __builtin_amdgcn_sched_barrier(0);
            float mx[2], lsum[2];
#pragma unroll
            for (int g = 0; g < 2; ++g) {
                float m_ = -1e30f;
                int lo = 16 * g + qi, hi = 128 + 16 * g + qi; lo = lo > -ws_ ? lo : -ws_; hi = hi < L - 1 - ws_ ? hi : L - 1 - ws_;
                const int lo8 = lo - 8 * kq; const unsigned span = (unsigned)(hi - lo);
#pragma unroll
                for (int t = 0; t < 10; ++t)
#pragma unroll
                    for (int i = 0; i < 4; ++i) {
                        const int c = 32 * (t >> 1) + 4 * (t & 1) + i;
                        const bool ok = (unsigned)(c - lo8) <= span;
                        const float v = ok ? s[g][t][i] : -1e30f; s[g][t][i] = v; m_ = fmaxf(m_, v);
                    }
                m_ = fmaxf(m_, __shfl_xor(m_, 16)); m_ = fmaxf(m_, __shfl_xor(m_, 32));
                float l_ = 0.f;
#pragma unroll
                for (int t = 0; t < 10; ++t)
#pragma unroll
                    for (int i = 0; i < 4; ++i) { const float pv = __builtin_amdgcn_exp2f(s[g][t][i] - m_); s[g][t][i] = pv; l_ += pv; }
                l_ += __shfl_xor(l_, 16); l_ += __shfl_xor(l_, 32);
                mx[g] = m_; lsum[g] = l_;
            }
            f32x4 o[2][4];
#pragma unroll
            for (int g = 0; g < 2; ++g)
#pragma unroll
                for (int dt = 0; dt < 4; ++dt) o[g][dt] = (f32x4){0.f, 0.f, 0.f, 0.f};
#pragma unroll
            for (int c = 0; c < 5; ++c)
#pragma unroll
                for (int g = 0; g < 2; ++g) {
                    union { u32x4 u; bf16x8 v; } pf;
                    pf.u.x = cvt_pk_bf16(s[g][2 * c][0], s[g][2 * c][1]); pf.u.y = cvt_pk_bf16(s[g][2 * c][2], s[g][2 * c][3]);
                    pf.u.z = cvt_pk_bf16(s[g][2 * c + 1][0], s[g][2 * c + 1][1]); pf.u.w = cvt_pk_bf16(s[g][2 * c + 1][2], s[g][2 * c + 1][3]);
#pragma unroll
                    for (int dt = 0; dt < 4; ++dt) o[g][dt] = __builtin_amdgcn_mfma_f32_16x16x32_bf16(vf[c][dt], pf.v, o[g][dt], 0, 0, 0);
                }
#pragma unroll
            for (int g = 0; g < 2; ++g) {
                const int tl = qtok[g] - T0;
                LAS float* orow = Oacc + tl * OP + 4 * kq;
                if (p == 0) {
#pragma unroll
                    for (int dt = 0; dt < 4; ++dt) *(LAS f32x4*)(orow + 16 * dt) = o[g][dt];
                    if (kq == 0) { Ml[2 * tl] = mx[g]; Ml[2 * tl + 1] = lsum[g]; }
                } else {
                    const float mo = Ml[2 * tl], lo = Ml[2 * tl + 1];
                    const float mn = fmaxf(mo, mx[g]), fa = __builtin_amdgcn_exp2f(mo - mn), fb = __builtin_amdgcn_exp2f(mx[g] - mn);
                    f32x4 om[4];
#pragma unroll
                    for (int dt = 0; dt < 4; ++dt) om[dt] = *(const LAS f32x4*)(orow + 16 * dt) * fa + o[g][dt] * fb;
                    const float ln = lo * fa + lsum[g] * fb;
                    asm volatile("s_waitcnt lgkmcnt(0)" ::: "memory");
#pragma unroll
                    for (int dt = 0; dt < 4; ++dt) *(LAS f32x4*)(orow + 16 * dt) = om[dt];
                    if (kq == 0) { Ml[2 * tl] = mn; Ml[2 * tl + 1] = ln; }
                }
            }
        }
        __syncthreads();
    }
#pragma unroll 1
    for (int ps = 0; ps < ABLK / 256; ++ps) {
      const int tid = wid * 64 + lane, tl = ps * 256 + (tid >> 1), half = tid & 1;
      const float inv = 1.0f / Ml[2 * tl + 1]; const LAS float* orow = Oacc + tl * OP + 32 * half; float part = 0.f;
      bf16_t* op = MIX + (tb + T0 + tl) * DM + h * 64 + 32 * half;
#pragma unroll
      for (int j = 0; j < 4; ++j) { const f32x4 va = *(const LAS f32x4*)(orow + 8 * j) * inv, vb = *(const LAS f32x4*)(orow + 8 * j + 4) * inv;
          part += (va[0] * va[0] + va[1] * va[1]) + (va[2] * va[2] + va[3] * va[3]) + (vb[0] * vb[0] + vb[1] * vb[1]) + (vb[2] * vb[2] + vb[3] * vb[3]);
          u32x4 w; w.x = cvt_pk_bf16(va[0], va[1]); w.y = cvt_pk_bf16(va[2], va[3]); w.z = cvt_pk_bf16(vb[0], vb[1]); w.w = cvt_pk_bf16(vb[2], vb[3]); *(u32x4*)(op + 8 * j) = w; }
      part += __shfl_xor(part, 1);
      if (half == 0) fx_add(ssq_a + tb + T0 + tl, part);
    }
    __syncthreads();
}

constexpr int SGU_TAB = 131072;
__device__ __forceinline__ void sgu_unit(LAS unsigned char* lds, int tok0, const bf16_t* Gt, const bf16_t* U, const bf16_t* Wb, const float* bs, const float* lng, const float* lnb,
                                         const i64* lnsum, const i64* lnsq, bf16_t* MIX, int wid, int lane_in) {
    int lane = lane_in; asm volatile("" : "+v"(lane));
    LAS float* MU = (LAS float*)(lds + SGU_TAB); LAS float* RS = MU + 128; LAS float* SS = RS + 128;
    const int tid = wid * 64 + lane;
#pragma unroll
    for (int i = 0; i < 16; ++i) { const int P = ((i * 8 + wid) << 6) + lane, row = P >> 4, piece = (P & 15) ^ (row & 15);
        __builtin_amdgcn_global_load_lds((const unsigned*)(Wb + (size_t)row * 128 + piece * 8), (LAS unsigned*)(lds + (i * 8 + wid) * 1024), 16, 0, 0); }
    const int g = wid >> 1, e0 = 64 * (wid & 1), li = lane & 15, kq = lane >> 4;
    float gg[4], gb[4]; u32x4 rawg[4][4];
#pragma unroll
    for (int et = 0; et < 4; ++et) { const int ch = g * 128 + e0 + 16 * (li >> 2) + 4 * et + (li & 3);
        gg[et] = lng[ch]; gb[et] = lnb[ch];
#pragma unroll
        for (int c = 0; c < 4; ++c) rawg[c][et] = *(const u32x4*)(Gt + ((size_t)((tok0 + 32 * c + 8 * kq) >> 3) * 512 + ch) * 8); }
    if (tid < 128) { const float sm = fx_get(lnsum + tok0 + tid) * (1.0f / DH); const float var = fx_get(lnsq + tok0 + tid) * (1.0f / DH) - sm * sm;
        MU[tid] = sm; RS[tid] = __builtin_amdgcn_rsqf(fmaxf(var, 0.f) + EPS); }
    asm volatile("s_waitcnt vmcnt(0)" ::: "memory");
    __syncthreads();
    f32x4 acc[4][8];
#pragma unroll
    for (int et = 0; et < 4; ++et)
#pragma unroll
        for (int tt = 0; tt < 8; ++tt) acc[et][tt] = (f32x4){0.f, 0.f, 0.f, 0.f};
    const LAS unsigned char* wrow = lds + (size_t)(g * 128 + li) * 256;
#pragma unroll
    for (int c = 0; c < 4; ++c) {
        const int s0 = 32 * c + 8 * kq;
        const f32x4 mu0 = *(const LAS f32x4*)(MU + s0), mu1 = *(const LAS f32x4*)(MU + s0 + 4), rs0 = *(const LAS f32x4*)(RS + s0), rs1 = *(const LAS f32x4*)(RS + s0 + 4);
        bf16x8 af[4];
#pragma unroll
        for (int et = 0; et < 4; ++et) {
            const u32x4 raw = rawg[c][et];
            f32x4 x0, x1;
            x0[0] = __uint_as_float(raw.x << 16); x0[1] = __uint_as_float(raw.x & 0xffff0000u); x0[2] = __uint_as_float(raw.y << 16); x0[3] = __uint_as_float(raw.y & 0xffff0000u);
            x1[0] = __uint_as_float(raw.z << 16); x1[1] = __uint_as_float(raw.z & 0xffff0000u); x1[2] = __uint_as_float(raw.w << 16); x1[3] = __uint_as_float(raw.w & 0xffff0000u);
            x0 = (x0 - mu0) * rs0 * gg[et] + gb[et]; x1 = (x1 - mu1) * rs1 * gg[et] + gb[et];
            union { u32x4 u; bf16x8 v; } pk;
            pk.u.x = cvt_pk_bf16(x0[0], x0[1]); pk.u.y = cvt_pk_bf16(x0[2], x0[3]); pk.u.z = cvt_pk_bf16(x1[0], x1[1]); pk.u.w = cvt_pk_bf16(x1[2], x1[3]);
            af[et] = pk.v;
        }
#pragma unroll
        for (int tt = 0; tt < 8; ++tt) {
            const bf16x8 wf = *(const LAS bf16x8*)(wrow + tt * 4096 + (((4 * c + kq) ^ li) << 4));
#pragma unroll
            for (int et = 0; et < 4; ++et) acc[et][tt] = __builtin_amdgcn_mfma_f32_16x16x32_bf16(af[et], wf, acc[et][tt], 0, 0, 0);
        }
    }
    u32x4 uraw[8][2]; float biasv[8];
#pragma unroll
    for (int tt = 0; tt < 8; ++tt) { biasv[tt] = bs[g * 128 + 16 * tt + li];
        const bf16_t* up = U + (size_t)(tok0 + 16 * tt + li) * DH + g * 128 + e0 + 16 * kq;
        uraw[tt][0] = *(const u32x4*)up; uraw[tt][1] = *(const u32x4*)(up + 8); }
    __builtin_amdgcn_sched_barrier(0);
#pragma unroll
    for (int tt = 0; tt < 8; ++tt) {
        const int t = 16 * tt + li; const float bias = biasv[tt]; float part = 0.f;
#pragma unroll
        for (int et = 0; et < 4; ++et) {
            const unsigned r0 = (et & 1) ? uraw[tt][et >> 1].z : uraw[tt][et >> 1].x, r1 = (et & 1) ? uraw[tt][et >> 1].w : uraw[tt][et >> 1].y;
            f32x4 uv; uv[0] = __uint_as_float(r0 << 16); uv[1] = __uint_as_float(r0 & 0xffff0000u); uv[2] = __uint_as_float(r1 << 16); uv[3] = __uint_as_float(r1 & 0xffff0000u);
            const f32x4 v = uv * (acc[et][tt] + bias); acc[et][tt] = v;
            part += (v[0] * v[0] + v[1] * v[1]) + (v[2] * v[2] + v[3] * v[3]);
        }
        part += __shfl_xor(part, 16); part += __shfl_xor(part, 32);
        if (kq == 0) SS[wid * 128 + t] = part;
    }
    __syncthreads();
#pragma unroll
    for (int tt = 0; tt < 8; ++tt) {
        const int t = 16 * tt + li; float tot = 0.f;
#pragma unroll
        for (int w8 = 0; w8 < 8; ++w8) tot += SS[w8 * 128 + t];
        const float rstd = __builtin_amdgcn_rsqf(tot * (1.0f / DH) + EPS);
        bf16_t* mp = MIX + (size_t)(tok0 + t) * DM + DH + g * 128 + e0 + 16 * kq;
#pragma unroll
        for (int eh = 0; eh < 2; ++eh) { const f32x4 va = acc[2 * eh][tt] * rstd, vb = acc[2 * eh + 1][tt] * rstd;
            u32x4 w; w.x = cvt_pk_bf16(va[0], va[1]); w.y = cvt_pk_bf16(va[2], va[3]); w.z = cvt_pk_bf16(vb[0], vb[1]); w.w = cvt_pk_bf16(vb[2], vb[3]); *(u32x4*)(mp + 8 * eh) = w; }
    }
    __syncthreads();
}

#define XB_TMO      128
#define XB_XCNT(j)  (256  + 64 * (j))
#define XB_XSUB(j)  (1280 + 64 * (j))
#define XB_XGEN(j)  (2304 + 64 * (j))
#define XB_TOP      3328
#define XB_TOPGEN   3392
#define XCD_BAR_WORDS 3456
#define XB_SPIN_CAP (1u << 18)

__device__ __forceinline__ unsigned xb_ld(unsigned* p)              { return __hip_atomic_load(p, __ATOMIC_RELAXED, __HIP_MEMORY_SCOPE_AGENT); }
__device__ __forceinline__ unsigned xb_add(unsigned* p, unsigned v) { return __hip_atomic_fetch_add(p, v, __ATOMIC_RELAXED, __HIP_MEMORY_SCOPE_AGENT); }
__device__ __forceinline__ unsigned xb_xcc_id() { return (unsigned)__builtin_amdgcn_s_getreg((3 << 11) | 20) & 0xFu; }
#define XB_SPIN(cond, bar) do { unsigned _sp = 0; while (cond) { __builtin_amdgcn_s_sleep(1); \
    if ((++_sp & 255u) == 0u) { if (xb_ld(&(bar)[XB_TMO])) break; if (_sp > XB_SPIN_CAP) { atomicAdd(&(bar)[XB_TMO], 1u); break; } } } } while (0)

struct XcdBarrier {
    unsigned* bar; unsigned x;
    volatile LAS unsigned* st;
};

__device__ __forceinline__ XcdBarrier xcd_barrier_post(unsigned* bar, volatile LAS unsigned* st) {
    XcdBarrier b; b.bar = bar; b.x = xb_xcc_id(); b.st = st;
    if (threadIdx.x == 0) (void)xb_add(&bar[XB_XCNT(b.x)], 1u);
    return b;
}
__device__ __forceinline__ void xcd_barrier_complete(unsigned* bar, unsigned x, unsigned& nloc, unsigned& nx) {
    const unsigned G = gridDim.x * gridDim.y * gridDim.z;
    unsigned sum, cnt, mine, sp = 0u;
    for (;;) {
        sum = 0u; cnt = 0u; mine = 0u;
#pragma unroll
        for (unsigned j = 0; j < 16; ++j) { const unsigned c = xb_ld(&bar[XB_XCNT(j)]); sum += c; cnt += (c > 0u) ? 1u : 0u; mine = (j == x) ? c : mine; }
        if (sum == G) break;
        __builtin_amdgcn_s_sleep(1);
        if ((++sp & 255u) == 0u) { if (xb_ld(&bar[XB_TMO])) break; if (sp > XB_SPIN_CAP) { atomicAdd(&bar[XB_TMO], 1u); break; } }
    }
    nloc = mine > 0u ? mine : 1u; nx = cnt > 0u ? cnt : 1u;
}

__device__ __forceinline__ void xcd_barrier(const XcdBarrier& b) {
    asm volatile("s_waitcnt vmcnt(0)" ::: "memory");
    __syncthreads();
    if (threadIdx.x == 0) {
        unsigned* bar = b.bar;
        __builtin_amdgcn_s_waitcnt(0);
        unsigned nloc = b.st[0], nx = b.st[1];
        if (nloc == 0u) { xcd_barrier_complete(bar, b.x, nloc, nx); b.st[0] = nloc; b.st[1] = nx; }
        const unsigned old = xb_add(&bar[XB_XSUB(b.x)], 1u);
        const unsigned gen = old / nloc;
        if (old + 1u == (gen + 1u) * nloc) {
            __builtin_amdgcn_fence(__ATOMIC_RELEASE, "agent");
            asm volatile("s_waitcnt vmcnt(0)" ::: "memory");
            const unsigned og = xb_add(&bar[XB_TOP], 1u);
            const unsigned tg = og / nx;
            if (og + 1u == (tg + 1u) * nx) xb_add(&bar[XB_TOPGEN], 1u);
            else XB_SPIN(xb_ld(&bar[XB_TOPGEN]) == tg, bar);
            __builtin_amdgcn_fence(__ATOMIC_ACQUIRE, "agent");
            xb_add(&bar[XB_XGEN(b.x)], 1u);
            asm volatile("s_waitcnt vmcnt(0)" ::: "memory");
        } else {
            XB_SPIN(xb_ld(&bar[XB_XGEN(b.x)]) == gen, bar);
            __builtin_amdgcn_fence(__ATOMIC_ACQUIRE, "agent");
            asm volatile("s_waitcnt vmcnt(0)" ::: "memory");
        }
    }
    __syncthreads();
}

constexpr int RSL_OFF = 131072, RSL_UNITS = 6;
template <bool BY_COL> __device__ __forceinline__ void stage_rstd(LAS unsigned char* lds, const pg8::StaticOrder& S, const i64* ssq) {
    LAS float* rsl = (LAS float*)(lds + RSL_OFF); const int tid = threadIdx.x;
#pragma unroll 1
    for (int i = 0; i < RSL_UNITS; ++i) { Unit u; if (!S.next(i, u)) break;
        if (tid < 256) rsl[i * 256 + tid] = __builtin_amdgcn_rsqf(fx_get(ssq + (BY_COL ? u.pn : u.pm) * 256 + tid) * (1.0f / DM) + EPS); }
    __syncthreads();
}

constexpr int PH_PER_LAYER = 7, N_PHASES = 1 + DEPTH * PH_PER_LAYER + 1;

__global__ void __launch_bounds__(NWAVES * 64, 2) fwd_kernel(Args a) {
    extern __shared__ __attribute__((aligned(16))) unsigned char lds_raw[];
    LAS unsigned char* lds = (LAS unsigned char*)lds_raw;
    const int G = gridDim.x, cu = blockIdx.x;
    const int lo = a.ph_lo, hi = a.ph_hi;
    const bool spread = (G == 256) && MK_ONE;
#define IDLE_CONVERT(slot) do { if (spread && cu >= 128) { __builtin_amdgcn_sched_barrier(0); int tid_ = threadIdx.x; asm volatile("" : "+v"(tid_) :: "memory"); const int wave_ = __builtin_amdgcn_readfirstlane(tid_ >> 6); \
        const int NW_ = 128 * NWAVES, w_ = (cu - 128) * NWAVES + wave_; \
        const int l1_ = l, lo1_ = (slot) == 0 ? 2 * I_GU : ((slot) == 1 ? I_LAYER - I_OUT : 2 * I_GU + I_D), n1_ = (slot) == 0 ? I_D : ((slot) == 1 ? I_OUT : I_D); \
        const int l2_ = (slot) == 2 ? l + 1 : l, lo2_ = (slot) == 0 ? 2 * I_GU + 2 * I_D : ((slot) == 1 ? I_GU : 0), n2_ = (slot) == 0 ? I_INN + I_INS : I_GU; \
        convert_weights(a, lds, l1_, lo1_, lo1_ + n1_, w_, NW_, wave_, tid_ & 63); \
        if (l2_ < DEPTH) convert_weights(a, lds, l2_, lo2_, lo2_ + n2_, (w_ + NW_ - (n1_ % NW_)) % NW_, NW_, wave_, tid_ & 63); \
        __syncthreads(); } } while (0)
#if MK_ONE
    cg::grid_group grid = cg::this_grid();
    { volatile LAS unsigned* misc = (volatile LAS unsigned*)(lds + MISC_OFF); if (threadIdx.x < 32) misc[threadIdx.x] = 0u; __syncthreads(); }
    XcdBarrier bar; bar.bar = (unsigned*)(as_global(a.ws) + WS_BAR); bar.x = xb_xcc_id(); bar.st = (volatile LAS unsigned*)(lds + MISC_OFF) + 8;
#define SEAM(k) do { if ((k) + 1 < hi) { if ((k) == 0) grid.sync(); else { xcd_barrier(bar); if (DUP & 4) xcd_barrier(bar); } } } while (0)
#else
#define SEAM(k) do { } while (0)
#endif
#define IN(k) (lo <= (k) && (k) < hi)
#define WSBASE() GAS unsigned char* wsg_ = (GAS unsigned char*)a.ws; asm volatile("" : "+s"(wsg_)); unsigned char* ws = (unsigned char*)wsg_; i64* stats = (i64*)(ws + WS_STATS); i64* st = stats + (size_t)(6 * l) * MTOK; unsigned char* wl = ws + WS_W + (size_t)l * WL_STRIDE; (void)st; (void)wl

    if (!(SKIP & 32) && IN(0)) {
        const int tid = threadIdx.x, lane = tid & 63, wave = __builtin_amdgcn_readfirstlane(tid >> 6);
        prologue(a, lds, cu * NWAVES + wave, G * NWAVES, wave, lane, spread ? -1 : DEPTH); __syncthreads();
        if (DUP & 8) { prologue(a, lds, cu * NWAVES + wave, G * NWAVES, wave, lane, spread ? -1 : DEPTH); __syncthreads(); }
#if MK_ONE
        if (cu == 0) { unsigned* bw = (unsigned*)(as_global(a.ws) + WS_BAR); for (int i = tid; i < (int)(BAR_BYTES / 4); i += NWAVES * 64) bw[i] = 0u; }
        grid.sync();
        if (tid == 0) (void)xb_add(&bar.bar[XB_XCNT(bar.x)], 1u);
#endif
    }

#pragma unroll 1
    for (int l = 0; l < DEPTH; ++l) {
        const int pb = 1 + l * PH_PER_LAYER;
#pragma unroll 1
        for (int f = 0; f < 2; ++f) {
            const int p0 = pb + (f ? 5 : 0);
            if (!(SKIP & 1) && IN(p0)) {
                WSBASE();
                pg8::Gemm g{(const bf16_t*)(ws + WS_XB), (const bf16_t*)(wl + (f ? WL_GU2 : WL_GU1)), MTOK, NGU, DM}; pg8::StaticOrder S; S.init(MTOK, NGU, G, cu);
                stage_rstd<false>(lds, S, st + (f ? 5 : 0) * MTOK);
                EpiSwiGLU E{(bf16_t*)(ws + WS_H), (const LAS float*)(lds + RSL_OFF)};
                pg8::gemm_phase<EpiSwiGLU, pg8::StaticOrder, true>(lds, g, S, E);
                if (DUP & 32) pg8::gemm_phase<EpiSwiGLU, pg8::StaticOrder, true>(lds, g, S, E);
                if (DUP & 256) { EpiNull EN; pg8::gemm_phase<EpiNull, pg8::StaticOrder, true>(lds, g, S, EN); }
                IDLE_CONVERT(f ? 2 : 0);
                SEAM(p0);
            }
            if (!(SKIP & 64) && IN(p0 + 1)) {
                WSBASE();
                pg8::Gemm g{(const bf16_t*)(ws + WS_H), (const bf16_t*)(wl + (f ? WL_D2 : WL_D1)), MTOK, DM, DFF}; pg8::StaticOrder S; S.init(MTOK, DM, G, cu);
                if (FUSE_FINAL && l == DEPTH - 1 && f == 1 && G == 256) {
                    EpiFinal E{as_global(a.out), as_global(a.out), st + 6 * MTOK, (unsigned*)(stats + (size_t)25 * MTOK), as_global(a.in[18]), 0.5f};
                    pg8::gemm_phase<EpiFinal, pg8::StaticOrder, true>(lds, g, S, E);
                } else {
                    EpiResid<-1> E{(l == 0 && f == 0) ? as_global(a.in[0]) : (const float*)as_global(a.out), as_global(a.out), (bf16_t*)(ws + WS_XB), st + (f ? 6 : 1) * MTOK, nullptr, 0.5f};
                    pg8::gemm_phase<EpiResid<-1>, pg8::StaticOrder, true>(lds, g, S, E);
                    SEAM(p0 + 1);
                }
            }
            if (f == 1) break;
            if (!(SKIP & 2) && IN(pb + 2)) {
                { WSBASE();
                  pg8::Gemm g{(const bf16_t*)(ws + WS_XB), (const bf16_t*)(wl + WL_INN), MTOK, 1536, DM}; pg8::StaticOrder S; S.init(MTOK, 1536, G, cu);
                  stage_rstd<false>(lds, S, st + 1 * MTOK);
                  EpiQKU E{(bf16_t*)(ws + WS_Q), (const LAS float*)(lds + RSL_OFF), (const float*)(ws + WS_ROT), (const float*)(ws + WS_ROT) + SEQ * 8};
                  pg8::gemm_phase<EpiQKU, pg8::StaticOrder, true>(lds, g, S, E);
                  if (DUP & 16) pg8::gemm_phase<EpiQKU, pg8::StaticOrder, true>(lds, g, S, E); }
                { WSBASE();
                  pg8::Gemm g{(const bf16_t*)(wl + WL_INS), (const bf16_t*)(ws + WS_XB), 1024, MTOK, DM}; pg8::StaticOrder S; S.init(1024, MTOK, G, G - 1 - cu);
                  stage_rstd<true>(lds, S, st + 1 * MTOK);
                  EpiVG E{(bf16_t*)(ws + WS_VT1), (bf16_t*)(ws + WS_VT4), (bf16_t*)(ws + WS_VT16), (bf16_t*)(ws + WS_GT), (const LAS float*)(lds + RSL_OFF), st + 3 * MTOK, st + 4 * MTOK};
                  pg8::gemm_phase<EpiVG, pg8::StaticOrder, true>(lds, g, S, E);
                  if (DUP & 16) { EpiVG E2 = E; E2.lnsum = stats + (size_t)30 * MTOK; E2.lnsq = stats + (size_t)31 * MTOK; pg8::gemm_phase<EpiVG, pg8::StaticOrder, true>(lds, g, S, E2); } }
                IDLE_CONVERT(1);
                SEAM(pb + 2);
            }
            if (IN(pb + 3)) {
                const int tid = threadIdx.x, lane = tid & 63, wave = __builtin_amdgcn_readfirstlane(tid >> 6);
                if (!(SKIP & 4)) { WSBASE();
                  for (int u = cu; u < 256; u += G) { const int j = u >> 3, bh = (u & 7) * 2 + (j >> 4), blk = j & 15;
                    attn_unit(lds, bh >> 3, bh & 7, blk, (const bf16_t*)(ws + WS_Q), (const bf16_t*)(ws + WS_K), (const bf16_t*)(ws + WS_VT1), (const bf16_t*)(ws + WS_VT4), (const bf16_t*)(ws + WS_VT16),
                              (bf16_t*)(ws + WS_MIX), st + 2 * MTOK, wave, lane);
                    if (DUP & 1) attn_unit(lds, bh >> 3, bh & 7, blk, (const bf16_t*)(ws + WS_Q), (const bf16_t*)(ws + WS_K), (const bf16_t*)(ws + WS_VT1), (const bf16_t*)(ws + WS_VT4), (const bf16_t*)(ws + WS_VT16),
                              (bf16_t*)(ws + WS_MIX), stats + (size_t)30 * MTOK, wave, lane); } }
                if (!(SKIP & 8)) { WSBASE();
                  for (int u = cu; u < MTOK / 128; u += G) for (int rp = 0; rp < ((DUP & 2) ? 2 : 1); ++rp)
                    sgu_unit(lds, u * 128, (const bf16_t*)(ws + WS_GT), (const bf16_t*)(ws + WS_U), (const bf16_t*)(ws + WS_SGUW) + (size_t)l * 4 * 16384, as_global(a.in[10]) + l * 512, as_global(a.in[7]) + l * DH, as_global(a.in[8]) + l * DH,
                             st + 3 * MTOK, st + 4 * MTOK, (bf16_t*)(ws + WS_MIX), wave, lane); }
                SEAM(pb + 3);
            }
            if (!(SKIP & 16) && IN(pb + 4)) {
                WSBASE();
                pg8::Gemm g{(const bf16_t*)(ws + WS_MIX), (const bf16_t*)(wl + WL_OUT), MTOK, DM, DM}; pg8::StaticOrder S; S.init(MTOK, DM, G, cu);
                EpiResid<8> E{as_global(a.out), as_global(a.out), (bf16_t*)(ws + WS_XB), st + 5 * MTOK, st + 2 * MTOK, 1.0f};
                pg8::gemm_phase<EpiResid<8>, pg8::StaticOrder, true>(lds, g, S, E);
                SEAM(pb + 4);
            }
        }
    }
    if (IN(N_PHASES - 1) && !(FUSE_FINAL && G == 256)) {
        const int tid = threadIdx.x, lane = tid & 63, wave = __builtin_amdgcn_readfirstlane(tid >> 6);
        const i64* fs = (const i64*)(as_global(a.ws) + WS_STATS) + (size_t)24 * MTOK; const f32x4* gn = (const f32x4*)as_global(a.in[18]) + lane;
        for (int m = cu * NWAVES + wave; m < MTOK; m += G * NWAVES) {
            const float rs = __builtin_amdgcn_rsqf(fx_get(fs + m) * (1.0f / DM) + EPS);
            f32x4* xr = (f32x4*)(as_global(a.out) + (size_t)m * DM) + lane;
            f32x4 xv[4];
#pragma unroll
            for (int j = 0; j < 4; ++j) xv[j] = xr[64 * j] * gn[64 * j];
#pragma unroll
            for (int j = 0; j < 4; ++j) xr[64 * j] = xv[j] * rs;
        }
    }
#undef IN
#undef SEAM
#undef WSBASE
#undef IDLE_CONVERT
}

extern "C" void kernel_launch(void* const* d_in, const int* in_sizes, int n_in, void* d_out, int out_size, void* d_ws, size_t ws_size, hipStream_t stream) {
    static int grid = 0;
    if (grid == 0) {
        if (n_in != 19 || out_size != MTOK * DM || ws_size < WS_END) { fprintf(stderr, "kernel_launch: unexpected shapes (n_in %d out %d ws %zu); nothing launched\n", n_in, out_size, ws_size); grid = -1; return; }
        int dev = 0, cus = 0, per_cu = 0;
        hipGetDevice(&dev); hipDeviceGetAttribute(&cus, hipDeviceAttributeMultiprocessorCount, dev);
        if (hipFuncSetAttribute((const void*)fwd_kernel, hipFuncAttributeMaxDynamicSharedMemorySize, LDS_BYTES) != hipSuccess) { fprintf(stderr, "kernel_launch: hipFuncSetAttribute failed\n"); grid = -1; return; }
        hipOccupancyMaxActiveBlocksPerMultiprocessor(&per_cu, (const void*)fwd_kernel, NWAVES * 64, LDS_BYTES);
        (void)hipGetLastError();
        if (per_cu < 1) fprintf(stderr, "kernel_launch: occupancy query says %d blocks per CU\n", per_cu);
        grid = cus > 0 ? cus : 256;
    }
    if (grid < 0) return;
    Args a{};
    for (int i = 0; i < 19; ++i) a.in[i] = (const float*)d_in[i];
    a.out = (float*)d_out; a.ws = (unsigned char*)d_ws;
#if MK_ONE
    a.ph_lo = 0; a.ph_hi = N_PHASES;
    void* args[] = {&a};
    hipError_t e = hipLaunchCooperativeKernel((const void*)fwd_kernel, dim3(grid), dim3(NWAVES * 64), args, LDS_BYTES, stream);
    if (e != hipSuccess) fprintf(stderr, "cooperative launch failed: %s (grid %d)\n", hipGetErrorString(e), grid);
#else
    for (int p = 0; p < N_PHASES; ++p) { a.ph_lo = p; a.ph_hi = p + 1; hipLaunchKernelGGL(fwd_kernel, dim3(grid), dim3(NWAVES * 64), LDS_BYTES, stream, a); }
#endif
}
```

```cpp
#include <hip/hip_runtime.h>
#include <hip/hip_cooperative_groups.h>
#include <cstdio>
#include <cstdint>
namespace cg = cooperative_groups;

#ifndef SKIP
#define SKIP 0
#endif
#ifndef DUP
#define DUP 0
#endif
#ifndef FUSE_FINAL
#define FUSE_FINAL 1
#endif
#ifndef MK_ONE
#define MK_ONE 1
#endif

namespace pg8 {
#define PG8_LAS __attribute__((address_space(3)))
typedef unsigned short bf16_t;
typedef short bf16x8 __attribute__((ext_vector_type(8)));
typedef float f32x4 __attribute__((ext_vector_type(4)));
typedef float f32x2 __attribute__((ext_vector_type(2)));
typedef unsigned u32x4 __attribute__((ext_vector_type(4)));
typedef unsigned u32x2 __attribute__((ext_vector_type(2)));
constexpr int BM = 256, BK = 64, HALF = 128, HTB = HALF * BK * 2, STAGE_BYTES = 8 * HTB, NXCD = 8, WGM = 8;

__host__ __device__ __forceinline__ int lds_byte(int r, int c) { const int st = (r >> 4) * 2 + (c >> 5), rr = r & 15, cc = c & 31, ob = rr * 64 + cc * 2; return st * 1024 + (ob ^ (((ob >> 9) & 1) << 5)); }
__host__ __device__ __forceinline__ void stage_rc(int b, int& R, int& C) { const int st = b / 1024, sb = b % 1024, swz = sb ^ (((sb >> 9) & 1) << 5); R = (st >> 1) * 16 + swz / 64; C = (st & 1) * 32 + (swz % 64) / 2; }
__host__ __device__ __forceinline__ int perm32(int rho) { const int n = rho >> 4, i = rho & 15; return 8 * (i >> 2) + 4 * n + (i & 3); }

struct Unit { int pm, pn; };
struct Gemm { const bf16_t* A; const bf16_t* Bt; int M, N, K; };

struct StaticOrder {
    int nM, nN, nwg, G, c;
    __host__ __device__ void init(int M, int N, int G_, int c_) { nM = M / BM; nN = N / BM; nwg = nM * nN; G = G_; c = c_; }
    __host__ __device__ bool next(int i, Unit& u) const {
        const long L = (long)i * G + c; if (L >= nwg) return false;
        int wgid = (int)L; { const int q = nwg / NXCD, r = nwg % NXCD, xcd = wgid % NXCD, off = wgid / NXCD; wgid = (xcd < r ? xcd * (q + 1) : r * (q + 1) + (xcd - r) * q) + off; }
        const int nig = WGM * nN, gid = wgid / nig, fm = gid * WGM, gsz = (nM - fm) < WGM ? (nM - fm) : WGM;
        u.pm = fm + ((wgid % nig) % gsz); u.pn = (wgid % nig) / gsz; return true;
    }
};

__device__ __forceinline__ unsigned cvt_pk_bf16(float lo, float hi) { unsigned r; asm volatile("v_cvt_pk_bf16_f32 %0, %1, %2" : "=v"(r) : "v"(lo), "v"(hi)); return r; }

__device__ __forceinline__ f32x2 gelu_pk(f32x2 v) {
    const f32x2 av = __builtin_elementwise_abs(v), d = av * 0.2316418882f + 1.0f;
    f32x2 t; t.x = __builtin_amdgcn_rcpf(d.x); t.y = __builtin_amdgcn_rcpf(d.y);
    f32x2 q = t * 0.5307027145f + (-0.7265760135f); q = q * t + 0.7107068705f; q = q * t + (-0.142248368f); q = q * t + 0.127414796f; q = q * t;
    const f32x2 s = (v * v) * (-0.72134752044f);
    f32x2 e; e.x = __builtin_amdgcn_exp2f(s.x); e.y = __builtin_amdgcn_exp2f(s.y);
    const f32x2 m = v * (q * e), r = v - m;
    f32x2 o; o.x = v.x < 0.f ? m.x : r.x; o.y = v.y < 0.f ? m.y : r.y; return o;
}
__device__ __forceinline__ f32x4 gelu4(f32x4 v) { f32x2 a = gelu_pk((f32x2){v[0], v[1]}), b = gelu_pk((f32x2){v[2], v[3]}); return (f32x4){a.x, a.y, b.x, b.y}; }

template <class Epi, class Sched, bool ALIGN_EPI = false>
__device__ __forceinline__ void gemm_phase(PG8_LAS unsigned char* lds, const Gemm g, const Sched& S, const Epi& E) {
    int tid_ = threadIdx.x; asm volatile("" : "+v"(tid_));
    const int tid = tid_, wid = __builtin_amdgcn_readfirstlane(tid >> 6), lane = tid & 63, wr = wid >> 2, wc = wid & 3, fr = lane & 15, fq = lane >> 4;
    const int K = g.K, nt = K / BK;
    unsigned voffA[2], voffB[2];
#pragma unroll
    for (int i = 0; i < 2; ++i) { int R, C; stage_rc(tid * 16 + i * 8192, R, C); const int Rb = Epi::PERM ? ((R & ~31) + perm32(R & 31)) : R;
        voffA[i] = (unsigned)(R * K + C) * 2u; voffB[i] = (unsigned)(Rb * K + C) * 2u; }
    const size_t kstep = (size_t)(BK * 2);
    const size_t hstep = (size_t)HALF * K * 2;
    const size_t tstep = 2 * hstep;
    const unsigned ldsw = (unsigned)wid * 1024u;
    const int aoff = lds_byte(wr * 64 + fr, fq * 8), boff = lds_byte(wc * 32 + fr, fq * 8);
#define PG8_SA(b, h) (((b) * 2 + (h)) * HTB)
#define PG8_SB(b, h) ((4 + (b) * 2 + (h)) * HTB)
#define PG8_STAGE(bufoff, gbase, voff) do { _Pragma("unroll") for (int _i = 0; _i < 2; ++_i) \
        __builtin_amdgcn_global_load_lds((const unsigned*)((const char*)(gbase) + (voff)[_i]), (PG8_LAS unsigned*)(lds + (bufoff) + ldsw + _i * 8192), 16, 0, 0); } while (0)
#define PG8_LDA(dst, b, h) do { _Pragma("unroll") for (int m = 0; m < 4; ++m) _Pragma("unroll") for (int k = 0; k < 2; ++k) dst[m][k] = *(const PG8_LAS bf16x8*)(lds + PG8_SA(b, h) + aoff + m * 2048 + k * 1024); } while (0)
#define PG8_LDB(dst, b, h) do { _Pragma("unroll") for (int n = 0; n < 2; ++n) _Pragma("unroll") for (int k = 0; k < 2; ++k) dst[n][k] = *(const PG8_LAS bf16x8*)(lds + PG8_SB(b, h) + boff + n * 2048 + k * 1024); } while (0)
#define PG8_MMA(ai, bj, At, Bt) do { __builtin_amdgcn_s_setprio(1); _Pragma("unroll") for (int m = 0; m < 4; ++m) _Pragma("unroll") for (int n = 0; n < 2; ++n) _Pragma("unroll") for (int k = 0; k < 2; ++k) \
        acc[ai][bj][m][n] = __builtin_amdgcn_mfma_f32_16x16x32_bf16(Bt[n][k], At[m][k], acc[ai][bj][m][n], 0, 0, 0); __builtin_amdgcn_s_setprio(0); } while (0)
#define PG8_WAIT_V(n) asm volatile("s_waitcnt vmcnt(" #n ")" ::: "memory")
#define PG8_WAIT_L(n) asm volatile("s_waitcnt lgkmcnt(" #n ")" ::: "memory")
#define PG8_BAR __builtin_amdgcn_s_barrier()
#define PG8_SCHED __builtin_amdgcn_sched_barrier(0)
    Unit cur, nxt; int ui = 0;
    if (!S.next(0, cur)) return;
    f32x4 acc[2][2][4][2];
#pragma unroll
    for (int a = 0; a < 2; ++a)
#pragma unroll
        for (int b = 0; b < 2; ++b)
#pragma unroll
            for (int m = 0; m < 4; ++m)
#pragma unroll
                for (int n = 0; n < 2; ++n) acc[a][b][m][n] = (f32x4){0.f, 0.f, 0.f, 0.f};
    bf16x8 At[4][2], B0[2][2], B1[2][2];
    const char* cA = (const char*)g.A + (size_t)cur.pm * tstep; const char* cB = (const char*)g.Bt + (size_t)cur.pn * tstep;
    {
        PG8_STAGE(PG8_SB(0, 0), cB, voffB); PG8_STAGE(PG8_SB(0, 1), cB + hstep, voffB); PG8_STAGE(PG8_SA(0, 0), cA, voffA); PG8_STAGE(PG8_SA(0, 1), cA + hstep, voffA);
        if (wr == 1) PG8_BAR;
        PG8_WAIT_V(2); PG8_BAR;
        PG8_STAGE(PG8_SB(1, 0), cB + kstep, voffB); PG8_STAGE(PG8_SA(1, 0), cA + kstep, voffA); PG8_STAGE(PG8_SB(1, 1), cB + hstep + kstep, voffB);
        PG8_WAIT_V(6); PG8_BAR;
    }
    for (;;) {
        const bool has_next = S.next(ui + 1, nxt);
        const char* nA = has_next ? (const char*)g.A + (size_t)nxt.pm * tstep : cA; const char* nB = has_next ? (const char*)g.Bt + (size_t)nxt.pn * tstep : cB;
        for (int t = 0; t < nt; t += 2) {
            const bool last = (t == nt - 2);
            const char* a1 = cA + (size_t)(t + 1) * kstep;
            const char* a2 = last ? nA : cA + (size_t)(t + 2) * kstep; const char* b2 = last ? nB : cB + (size_t)(t + 2) * kstep;
            const char* a3 = a2 + kstep; const char* b3 = b2 + kstep;
            if constexpr (Epi::MID_T > 0) { if (t == Epi::MID_T) E.mid(acc, cur, wr, fr); }
            PG8_LDB(B0, 0, 0); PG8_LDB(B1, 0, 1); PG8_SCHED; PG8_LDA(At, 0, 0); PG8_STAGE(PG8_SA(1, 1), a1 + hstep, voffA);
            PG8_WAIT_V(8); PG8_WAIT_L(0); PG8_BAR; PG8_MMA(0, 0, At, B0); PG8_MMA(0, 1, At, B1); PG8_BAR; PG8_SCHED;
            PG8_LDA(At, 0, 1); PG8_STAGE(PG8_SB(0, 0), b2, voffB); PG8_STAGE(PG8_SB(0, 1), b2 + hstep, voffB); PG8_STAGE(PG8_SA(0, 0), a2, voffA);
            PG8_WAIT_V(8); PG8_WAIT_L(0); PG8_BAR; PG8_MMA(1, 0, At, B0); PG8_MMA(1, 1, At, B1); PG8_BAR; PG8_SCHED;
            PG8_LDB(B0, 1, 0); PG8_LDB(B1, 1, 1); PG8_SCHED; PG8_LDA(At, 1, 0); PG8_STAGE(PG8_SA(0, 1), a2 + hstep, voffA);
            PG8_WAIT_V(8); PG8_WAIT_L(0); PG8_BAR; PG8_MMA(0, 0, At, B0); PG8_MMA(0, 1, At, B1); PG8_BAR; PG8_SCHED;
            PG8_LDA(At, 1, 1); PG8_STAGE(PG8_SB(1, 0), b3, voffB); PG8_STAGE(PG8_SB(1, 1), b3 + hstep, voffB); PG8_STAGE(PG8_SA(1, 0), a3, voffA);
            PG8_WAIT_V(8); PG8_WAIT_L(0); PG8_BAR; PG8_MMA(1, 0, At, B0); PG8_MMA(1, 1, At, B1); PG8_BAR; PG8_SCHED;
        }
        if constexpr (ALIGN_EPI) { if (wr == 0) PG8_BAR; }
        E(acc, cur, wr, wc, fr, fq, ui);
        if (!has_next) break;
#pragma unroll
        for (int a = 0; a < 2; ++a)
#pragma unroll
            for (int b = 0; b < 2; ++b)
#pragma unroll
                for (int m = 0; m < 4; ++m)
#pragma unroll
                    for (int n = 0; n < 2; ++n) acc[a][b][m][n] = (f32x4){0.f, 0.f, 0.f, 0.f};
        cur = nxt; cA = nA; cB = nB; ++ui;
        if constexpr (ALIGN_EPI) { if (wr == 1) PG8_BAR; }
    }
    PG8_WAIT_V(0);
    if constexpr (!ALIGN_EPI) { if (wr == 0) PG8_BAR; }
    PG8_BAR;
#undef PG8_SA
#undef PG8_SB
#undef PG8_STAGE
#undef PG8_LDA
#undef PG8_LDB
#undef PG8_MMA
#undef PG8_WAIT_V
#undef PG8_WAIT_L
#undef PG8_BAR
#undef PG8_SCHED
}
}

using pg8::bf16_t; using pg8::bf16x8; using pg8::f32x4; using pg8::f32x2; using pg8::u32x4; using pg8::u32x2; using pg8::Unit; using pg8::cvt_pk_bf16;
#define LAS __attribute__((address_space(3)))
#define GAS __attribute__((address_space(1)))
template <class T> __device__ __forceinline__ T* as_global(T* p) { return (T*)(GAS T*)p; }

constexpr int MTOK = 16384, DM = 1024, SEQ = 8192, DFF = 2816, NGU = 2 * DFF, DEPTH = 4, DH = 512;
constexpr float EPS = 1e-6f, LOG2E = 1.4426950408889634f;
constexpr int NWAVES = 8;
constexpr int LDS_BYTES = 147456;

constexpr size_t MiB = 1u << 20;
constexpr size_t WS_STATS = 0;
constexpr size_t WS_ROT = 340 * MiB;
constexpr size_t WS_SGUW = 341 * MiB;
constexpr size_t WS_W = 4 * MiB;
constexpr size_t WL_GU1 = 0, WL_D1 = 11 * MiB, WL_INN = WL_D1 + 5 * MiB + 512 * 1024, WL_INS = WL_INN + 3 * MiB, WL_OUT = WL_INS + 2 * MiB, WL_GU2 = WL_OUT + 2 * MiB, WL_D2 = WL_GU2 + 11 * MiB, WL_STRIDE = 40 * MiB;
static_assert(WL_D2 + 5 * MiB + 512 * 1024 == WL_STRIDE, "weight map");
constexpr size_t WS_XB = 164 * MiB;
constexpr size_t WS_H = 196 * MiB;
constexpr size_t WS_Q = 196 * MiB, WS_K = 212 * MiB, WS_U = 228 * MiB, WS_VT1 = 244 * MiB, WS_VT4 = 260 * MiB, WS_VT16 = 276 * MiB, WS_GT = 292 * MiB, WS_MIX = 308 * MiB, WS_BAR = 342 * MiB, WS_END = 343 * MiB;
constexpr size_t BAR_BYTES = 16384;
constexpr int MISC_OFF = 143424;
constexpr int NSLOT = 26;

typedef long long i64;
constexpr float FX = 16777216.0f, FXI = 1.0f / 16777216.0f;
__device__ __forceinline__ void fx_add(i64* p, float v) { atomicAdd((unsigned long long*)p, (unsigned long long)(i64)(v * FX)); }
__device__ __forceinline__ float fx_get(const i64* p) { return (float)(*p) * FXI; }

struct Args { const float* in[19]; float* out; unsigned char* ws; int ph_lo, ph_hi; };

__device__ __forceinline__ float silu_mul(float g, float u) { return g * __builtin_amdgcn_rcpf(1.0f + __builtin_amdgcn_exp2f(-g * LOG2E)) * u; }

struct EpiSwiGLU {
    static constexpr bool PERM = true; static constexpr int MID_T = -1;
    bf16_t* H; const LAS float* rsl;
    __device__ __forceinline__ void mid(f32x4 (&)[2][2][4][2], const Unit&, int, int) const {}
    __device__ __forceinline__ void operator()(const f32x4 (&acc)[2][2][4][2], const Unit& u, int wr, int wc, int fr, int fq, int ui) const {
        const int row0 = u.pm * 256 + wr * 64 + fr, hc = u.pn * 128 + wc * 32 + 8 * fq;
#pragma unroll
        for (int ai = 0; ai < 2; ++ai)
#pragma unroll
            for (int m = 0; m < 4; ++m) {
                const int r = row0 + ai * 128 + m * 16; const float rs = rsl[ui * 256 + wr * 64 + fr + ai * 128 + m * 16];
                const f32x4 g0 = acc[ai][0][m][0] * rs, g1 = acc[ai][0][m][1] * rs, u0 = acc[ai][1][m][0] * rs, u1 = acc[ai][1][m][1] * rs;
                u32x4 w;
                w.x = cvt_pk_bf16(silu_mul(g0[0], u0[0]), silu_mul(g0[1], u0[1])); w.y = cvt_pk_bf16(silu_mul(g0[2], u0[2]), silu_mul(g0[3], u0[3]));
                w.z = cvt_pk_bf16(silu_mul(g1[0], u1[0]), silu_mul(g1[1], u1[1])); w.w = cvt_pk_bf16(silu_mul(g1[2], u1[2]), silu_mul(g1[3], u1[3]));
                *(u32x4*)(H + (size_t)r * DFF + hc) = w;
            }
    }
};

struct EpiNull {
    static constexpr bool PERM = true; static constexpr int MID_T = -1;
    __device__ __forceinline__ void mid(f32x4 (&)[2][2][4][2], const Unit&, int, int) const {}
    __device__ __forceinline__ void operator()(const f32x4 (&acc)[2][2][4][2], const Unit& u, int wr, int wc, int fr, int fq, int ui) const {
#pragma unroll
        for (int ai = 0; ai < 2; ++ai)
#pragma unroll
            for (int bj = 0; bj < 2; ++bj)
#pragma unroll
                for (int m = 0; m < 4; ++m) { asm volatile("" :: "v"(acc[ai][bj][m][0]), "v"(acc[ai][bj][m][1])); }
    }
};

template <int MIDT> struct EpiResid {
    static constexpr bool PERM = true; static constexpr int MID_T = MIDT;
    const float* Xin; float* X; bf16_t* XB; i64* ssq_out; const i64* mid_ssq; float alpha;
    __device__ __forceinline__ void mid(f32x4 (&acc)[2][2][4][2], const Unit& u, int wr, int fr) const {
        const int row0 = u.pm * 256 + wr * 64 + fr;
        i64 q[2][4];
#pragma unroll
        for (int ai = 0; ai < 2; ++ai)
#pragma unroll
            for (int m = 0; m < 4; ++m) q[ai][m] = mid_ssq[row0 + ai * 128 + m * 16];
#pragma unroll
        for (int ai = 0; ai < 2; ++ai)
#pragma unroll
            for (int m = 0; m < 4; ++m) { const float rs = __builtin_amdgcn_rsqf((float)q[ai][m] * FXI * (1.0f / DH) + EPS);
#pragma unroll
                for (int bj = 0; bj < 2; ++bj) { acc[ai][bj][m][0] = acc[ai][bj][m][0] * rs; acc[ai][bj][m][1] = acc[ai][bj][m][1] * rs; } }
    }
    __device__ __forceinline__ void operator()(const f32x4 (&acc)[2][2][4][2], const Unit& u, int wr, int wc, int fr, int fq, int ui) const {
        const int row0 = u.pm * 256 + wr * 64 + fr, col0 = u.pn * 256 + wc * 32 + 8 * fq;
#pragma unroll
        for (int ai = 0; ai < 2; ++ai) {
            f32x4 xv[4][2][2];
#pragma unroll
            for (int m = 0; m < 4; ++m)
#pragma unroll
                for (int bj = 0; bj < 2; ++bj) { const float* xp = Xin + (size_t)(row0 + ai * 128 + m * 16) * DM + col0 + bj * 128; xv[m][bj][0] = *(const f32x4*)xp; xv[m][bj][1] = *(const f32x4*)(xp + 4); }
            __builtin_amdgcn_sched_barrier(0);
#pragma unroll
            for (int m = 0; m < 4; ++m) {
                const int r = row0 + ai * 128 + m * 16; float part = 0.f;
#pragma unroll
                for (int bj = 0; bj < 2; ++bj) {
                    float* xp = X + (size_t)r * DM + col0 + bj * 128;
                    const f32x4 x0 = xv[m][bj][0] + acc[ai][bj][m][0] * alpha, x1 = xv[m][bj][1] + acc[ai][bj][m][1] * alpha;
                    *(f32x4*)xp = x0; *(f32x4*)(xp + 4) = x1;
                    part += (x0[0] * x0[0] + x0[1] * x0[1]) + (x0[2] * x0[2] + x0[3] * x0[3]) + (x1[0] * x1[0] + x1[1] * x1[1]) + (x1[2] * x1[2] + x1[3] * x1[3]);
                    u32x4 w; w.x = cvt_pk_bf16(x0[0], x0[1]); w.y = cvt_pk_bf16(x0[2], x0[3]); w.z = cvt_pk_bf16(x1[0], x1[1]); w.w = cvt_pk_bf16(x1[2], x1[3]);
                    *(u32x4*)(XB + (size_t)r * DM + col0 + bj * 128) = w;
                }
                part += __shfl_xor(part, 16); part += __shfl_xor(part, 32);
                if (fq == 0) fx_add(ssq_out + r, part);
            }
            __builtin_amdgcn_sched_barrier(0);
        }
    }
};

struct EpiFinal {
    static constexpr bool PERM = true; static constexpr int MID_T = -1;
    const float* Xin; float* Out; i64* ssq; unsigned* cnt; const float* gain; float alpha;
    __device__ __forceinline__ void mid(f32x4 (&)[2][2][4][2], const Unit&, int, int) const {}
    __device__ __forceinline__ void operator()(f32x4 (&acc)[2][2][4][2], const Unit& u, int wr, int wc, int fr, int fq, int ui) const {
        const int row0 = u.pm * 256 + wr * 64 + fr, col0 = u.pn * 256 + wc * 32 + 8 * fq;
#pragma unroll
        for (int ai = 0; ai < 2; ++ai) {
            f32x4 xv[4][2][2];
#pragma unroll
            for (int m = 0; m < 4; ++m)
#pragma unroll
                for (int bj = 0; bj < 2; ++bj) { const float* xp = Xin + (size_t)(row0 + ai * 128 + m * 16) * DM + col0 + bj * 128; xv[m][bj][0] = *(const f32x4*)xp; xv[m][bj][1] = *(const f32x4*)(xp + 4); }
            __builtin_amdgcn_sched_barrier(0);
#pragma unroll
            for (int m = 0; m < 4; ++m) {
                float part = 0.f;
#pragma unroll
                for (int bj = 0; bj < 2; ++bj) {
                    const f32x4 x0 = xv[m][bj][0] + acc[ai][bj][m][0] * alpha, x1 = xv[m][bj][1] + acc[ai][bj][m][1] * alpha;
                    acc[ai][bj][m][0] = x0; acc[ai][bj][m][1] = x1;
                    part += (x0[0] * x0[0] + x0[1] * x0[1]) + (x0[2] * x0[2] + x0[3] * x0[3]) + (x1[0] * x1[0] + x1[1] * x1[1]) + (x1[2] * x1[2] + x1[3] * x1[3]);
                }
                part += __shfl_xor(part, 16); part += __shfl_xor(part, 32);
                if (fq == 0) fx_add(ssq + row0 + ai * 128 + m * 16, part);
            }
        }
        asm volatile("s_waitcnt vmcnt(0)" ::: "memory");
        unsigned* cw = cnt + 64 * u.pm;
        if ((threadIdx.x & 63) == 0) __hip_atomic_fetch_add(cw, 1u, __ATOMIC_RELAXED, __HIP_MEMORY_SCOPE_AGENT);
        { unsigned sp = 0;
          while ((unsigned)__builtin_amdgcn_readfirstlane(__hip_atomic_load(cw, __ATOMIC_RELAXED, __HIP_MEMORY_SCOPE_AGENT)) < 32u) { __builtin_amdgcn_s_sleep(2); if (++sp > (1u << 20)) break; } }
        f32x4 gv[2][2];
#pragma unroll
        for (int bj = 0; bj < 2; ++bj) { gv[bj][0] = *(const f32x4*)(gain + col0 + bj * 128); gv[bj][1] = *(const f32x4*)(gain + col0 + bj * 128 + 4); }
        i64 q[2][4];
#pragma unroll
        for (int ai = 0; ai < 2; ++ai)
#pragma unroll
            for (int m = 0; m < 4; ++m) q[ai][m] = (i64)__hip_atomic_load((unsigned long long*)(ssq + row0 + ai * 128 + m * 16), __ATOMIC_RELAXED, __HIP_MEMORY_SCOPE_AGENT);
#pragma unroll
        for (int ai = 0; ai < 2; ++ai)
#pragma unroll
            for (int m = 0; m < 4; ++m) {
                const float rs = __builtin_amdgcn_rsqf((float)q[ai][m] * FXI * (1.0f / DM) + EPS);
                float* op = Out + (size_t)(row0 + ai * 128 + m * 16) * DM + col0;
#pragma unroll
                for (int bj = 0; bj < 2; ++bj) { *(f32x4*)(op + bj * 128) = acc[ai][bj][m][0] * rs * gv[bj][0]; *(f32x4*)(op + bj * 128 + 4) = acc[ai][bj][m][1] * rs * gv[bj][1]; }
            }
    }
};

struct EpiQKU {
    static constexpr bool PERM = true; static constexpr int MID_T = -1;
    bf16_t *Q; const LAS float* rsl; const float* rcos; const float* rsin;
    __device__ __forceinline__ void mid(f32x4 (&)[2][2][4][2], const Unit&, int, int) const {}
    __device__ __forceinline__ void operator()(const f32x4 (&acc)[2][2][4][2], const Unit& u, int wr, int wc, int fr, int fq, int ui) const {
        const int sect = u.pn >> 1; bf16_t* base = Q + (size_t)sect * 8388608;
        const int row0 = u.pm * 256 + wr * 64 + fr, colt = (u.pn & 1) * 256 + wc * 32 + 8 * fq;
        const bool rot = (sect < 2) && ((wc & 1) == 0);
        const float sgn = (fq == 0) ? -1.f : 1.f; const float osc = (sect == 0) ? 0.125f * LOG2E : 1.f;
#pragma unroll
        for (int ai = 0; ai < 2; ++ai)
#pragma unroll
            for (int m = 0; m < 4; ++m) {
                const int r = row0 + ai * 128 + m * 16; const float rs = rsl[ui * 256 + wr * 64 + fr + ai * 128 + m * 16];
                const int pos = r & (SEQ - 1);
                f32x4 c0, c1, s0, s1;
                if (rot) { c0 = *(const f32x4*)(rcos + pos * 8); c1 = *(const f32x4*)(rcos + pos * 8 + 4); s0 = *(const f32x4*)(rsin + pos * 8); s1 = *(const f32x4*)(rsin + pos * 8 + 4); }
#pragma unroll
                for (int bj = 0; bj < 2; ++bj) {
                    f32x4 v0 = acc[ai][bj][m][0] * rs, v1 = acc[ai][bj][m][1] * rs;
                    if (sect == 2) { v0 = pg8::gelu4(v0); v1 = pg8::gelu4(v1); }
                    else {
                        if (rot) {
                            f32x4 p0, p1;
#pragma unroll
                            for (int i = 0; i < 4; ++i) { p0[i] = __shfl_xor(v0[i], 16); p1[i] = __shfl_xor(v1[i], 16); }
                            if (fq < 2) { v0 = v0 * c0 + p0 * s0 * sgn; v1 = v1 * c1 + p1 * s1 * sgn; }
                        }
                        v0 = v0 * osc; v1 = v1 * osc;
                    }
                    u32x4 w; w.x = cvt_pk_bf16(v0[0], v0[1]); w.y = cvt_pk_bf16(v0[2], v0[3]); w.z = cvt_pk_bf16(v1[0], v1[1]); w.w = cvt_pk_bf16(v1[2], v1[3]);
                    const int cc = colt + bj * 128;
                    if (sect == 2) *(u32x4*)(base + (size_t)r * DH + cc) = w;
                    else *(u32x4*)(base + ((size_t)((r >> 13) * 8 + (cc >> 6)) * SEQ + (r & (SEQ - 1))) * 64 + (cc & 63)) = w;
                }
            }
    }
};

struct EpiVG {
    static constexpr bool PERM = true; static constexpr int MID_T = -1;
    bf16_t *Vt1, *Vt4, *Vt16, *Gt; const LAS float* rsl; i64* lnsum; i64* lnsq;
    __device__ __forceinline__ void mid(f32x4 (&)[2][2][4][2], const Unit&, int, int) const {}
    __device__ __forceinline__ void operator()(const f32x4 (&acc)[2][2][4][2], const Unit& u, int wr, int wc, int fr, int fq, int ui) const {
        const int sect = u.pm >> 1;
        const int ch0 = (u.pm & 1) * 256 + wr * 64 + fr;
#pragma unroll
        for (int bj = 0; bj < 2; ++bj) {
            const int tok = u.pn * 256 + wc * 32 + 8 * fq + bj * 128;
            const LAS float* rp = rsl + ui * 256 + wc * 32 + 8 * fq + bj * 128;
            const f32x4 rs0 = *(const LAS f32x4*)rp, rs1 = *(const LAS f32x4*)(rp + 4);
            if (sect == 0) {
                const int b_ = tok >> 13, t0 = tok & (SEQ - 1);
#pragma unroll
                for (int ai = 0; ai < 2; ++ai)
#pragma unroll
                    for (int m = 0; m < 4; ++m) {
                        const int ch = ch0 + ai * 128 + m * 16;
                        const size_t bhb = (size_t)(b_ * 8 + (ch >> 6)) * (SEQ * 64) + (size_t)(ch & 63) * 8;
                        const f32x4 v0 = acc[ai][bj][m][0] * rs0, v1 = acc[ai][bj][m][1] * rs1;
                        u32x4 w; w.x = cvt_pk_bf16(v0[0], v0[1]); w.y = cvt_pk_bf16(v0[2], v0[3]); w.z = cvt_pk_bf16(v1[0], v1[1]); w.w = cvt_pk_bf16(v1[2], v1[3]);
                        *(u32x4*)(Vt1 + bhb + (size_t)(t0 >> 3) * 512) = w;
                        { const unsigned a0 = cvt_pk_bf16(v0[0], v1[0]), a1 = cvt_pk_bf16(v0[1], v1[1]), a2 = cvt_pk_bf16(v0[2], v1[2]), a3 = cvt_pk_bf16(v0[3], v1[3]);
                          const bool odd = fq & 1;
                          const unsigned s0 = odd ? a0 : a2, s1 = odd ? a1 : a3;
                          const unsigned r0 = (unsigned)__shfl_xor((int)s0, 16), r1 = (unsigned)__shfl_xor((int)s1, 16);
                          const int n = (t0 & ~15) >> 2, rb = odd ? 2 : 0;
                          bf16_t* p4 = Vt4 + bhb + (size_t)(rb * 256 + (n >> 3)) * 512 + (n & 7);
                          u32x2 q0, q1; q0.x = odd ? r0 : a0; q0.y = odd ? a2 : r0; q1.x = odd ? r1 : a1; q1.y = odd ? a3 : r1;
                          *(u32x2*)p4 = q0; *(u32x2*)(p4 + (size_t)256 * 512) = q1; }
                        { const bool hi = fq & 2;
                          const unsigned s0 = hi ? w.x : w.z, s1 = hi ? w.y : w.w;
                          const unsigned r0 = (unsigned)__shfl_xor((int)s0, 32), r1 = (unsigned)__shfl_xor((int)s1, 32);
                          const unsigned lo0 = hi ? r0 : w.x, lo1 = hi ? r1 : w.y, hi0 = hi ? w.z : r0, hi1 = hi ? w.w : r1;
                          const int n = (t0 & ~31) >> 4, rb = (t0 & 8) + (hi ? 4 : 0);
                          bf16_t* p16 = Vt16 + bhb + (size_t)(rb * 64 + (n >> 3)) * 512 + (n & 7);
                          *(unsigned*)(p16 + (size_t)0 * 64 * 512) = (lo0 & 0xffffu) | (hi0 << 16);
                          *(unsigned*)(p16 + (size_t)1 * 64 * 512) = (lo0 >> 16) | (hi0 & 0xffff0000u);
                          *(unsigned*)(p16 + (size_t)2 * 64 * 512) = (lo1 & 0xffffu) | (hi1 << 16);
                          *(unsigned*)(p16 + (size_t)3 * 64 * 512) = (lo1 >> 16) | (hi1 & 0xffff0000u); }
                    }
            } else {
                f32x4 sm0 = (f32x4){0.f, 0.f, 0.f, 0.f}, sm1 = sm0, sq0 = sm0, sq1 = sm0;
#pragma unroll
                for (int ai = 0; ai < 2; ++ai)
#pragma unroll
                    for (int m = 0; m < 4; ++m) {
                        const int ch = ch0 + ai * 128 + m * 16;
                        const f32x4 v0 = pg8::gelu4(acc[ai][bj][m][0] * rs0), v1 = pg8::gelu4(acc[ai][bj][m][1] * rs1);
                        sm0 = sm0 + v0; sm1 = sm1 + v1; sq0 = sq0 + v0 * v0; sq1 = sq1 + v1 * v1;
                        u32x4 w; w.x = cvt_pk_bf16(v0[0], v0[1]); w.y = cvt_pk_bf16(v0[2], v0[3]); w.z = cvt_pk_bf16(v1[0], v1[1]); w.w = cvt_pk_bf16(v1[2], v1[3]);
                        *(u32x4*)(Gt + ((size_t)(tok >> 3) * 512 + ch) * 8) = w;
                    }
#pragma unroll
                for (int i = 0; i < 4; ++i) {
                    float a0 = sm0[i], a1 = sm1[i], b0 = sq0[i], b1 = sq1[i];
#pragma unroll
                    for (int o = 1; o < 16; o <<= 1) { a0 += __shfl_xor(a0, o); a1 += __shfl_xor(a1, o); b0 += __shfl_xor(b0, o); b1 += __shfl_xor(b1, o); }
                    if (fr == 0) { fx_add(lnsum + tok + i, a0); fx_add(lnsum + tok + 4 + i, a1); fx_add(lnsq + tok + i, b0); fx_add(lnsq + tok + 4 + i, b1); }
                }
            }
        }
    }
};

__device__ __forceinline__ float wave_sum(float v) {
#pragma unroll
    for (int o = 1; o < 64; o <<= 1) v += __shfl_xor(v, o);
    return v;
}
struct ConvItem { const float* src; const float* gain; bf16_t* dst; int Nsrc, K; };
constexpr int I_GU = 16 * (NGU / 64), I_D = (DFF / 64) * 16, I_INN = 16 * 24, I_INS = 16 * 16, I_OUT = 16 * 16;
constexpr int I_LAYER = 2 * I_GU + 2 * I_D + I_INN + I_INS + I_OUT;
__device__ __forceinline__ ConvItem conv_decode(const Args& a, int l, int it) {
    unsigned char* wl = as_global(a.ws) + WS_W + (size_t)l * WL_STRIDE;
    ConvItem c; int r = it;
    if (r < 2 * I_GU) {
        const int f = r / I_GU; r %= I_GU;
        const int kb = r / (NGU / 64), nb = r % (NGU / 64), n0d = 64 * nb, hb = n0d >> 7;
        const float* src = (hb & 1) ? as_global(a.in[f ? 16 : 3]) : as_global(a.in[f ? 15 : 2]);
        c.src = src + (size_t)l * DM * DFF + (size_t)(64 * kb) * DFF + (hb >> 1) * 128 + (n0d & 127); c.Nsrc = DFF; c.K = DM;
        c.gain = as_global(a.in[f ? 14 : 1]) + l * DM + 64 * kb; c.dst = (bf16_t*)(wl + (f ? WL_GU2 : WL_GU1)) + (size_t)n0d * DM + 64 * kb; return c;
    }
    r -= 2 * I_GU;
    if (r < 2 * I_D) {
        const int f = r / I_D; r %= I_D;
        const int kb = r / 16, nb = r % 16;
        c.src = as_global(a.in[f ? 17 : 4]) + (size_t)l * DFF * DM + (size_t)(64 * kb) * DM + 64 * nb; c.Nsrc = DM; c.K = DFF; c.gain = nullptr;
        c.dst = (bf16_t*)(wl + (f ? WL_D2 : WL_D1)) + (size_t)(64 * nb) * DFF + 64 * kb; return c;
    }
    r -= 2 * I_D;
    if (r < I_INN) {
        const int kb = r / 24, nb = r % 24, n0d = 64 * nb;
        c.src = as_global(a.in[6]) + (size_t)l * DM * 2560 + (size_t)(64 * kb) * 2560 + (n0d < 1024 ? n0d : n0d + 512); c.Nsrc = 2560; c.K = DM;
        c.gain = as_global(a.in[5]) + l * DM + 64 * kb; c.dst = (bf16_t*)(wl + WL_INN) + (size_t)n0d * DM + 64 * kb; return c;
    }
    r -= I_INN;
    if (r < I_INS) {
        const int kb = r / 16, nb = r % 16, n0d = 64 * nb;
        c.src = as_global(a.in[6]) + (size_t)l * DM * 2560 + (size_t)(64 * kb) * 2560 + (n0d < 512 ? 1024 + n0d : 1536 + n0d); c.Nsrc = 2560; c.K = DM;
        c.gain = as_global(a.in[5]) + l * DM + 64 * kb; c.dst = (bf16_t*)(wl + WL_INS) + (size_t)n0d * DM + 64 * kb; return c;
    }
    r -= I_INS;
    {
        const int kb = r / 16, nb = r % 16, k0 = 64 * kb;
        c.src = as_global(a.in[13]) + (size_t)l * DM * DM + (size_t)k0 * DM + 64 * nb; c.Nsrc = DM; c.K = DM;
        c.gain = k0 < 512 ? as_global(a.in[11]) + l * DH + k0 : as_global(a.in[12]) + l * DH + (k0 - 512);
        c.dst = (bf16_t*)(wl + WL_OUT) + (size_t)(64 * nb) * DM + k0; return c;
    }
}
__device__ __forceinline__ void conv_issue(const ConvItem& c, f32x4 (&v)[16], float (&gs)[16], int lane) {
#pragma unroll
    for (int i = 0; i < 16; ++i) { const int kk = 4 * i + (lane >> 4); v[i] = __builtin_nontemporal_load((const f32x4*)(c.src + (size_t)kk * c.Nsrc + 4 * (lane & 15))); gs[i] = c.gain ? c.gain[kk] : 1.0f; }
}
__device__ __forceinline__ void conv_finish(const ConvItem& c, const f32x4 (&v)[16], const float (&gs)[16], LAS float* scr, int lane) {
#pragma unroll
    for (int i = 0; i < 16; ++i) { const int kk = 4 * i + (lane >> 4); LAS float* d = scr + kk * 65 + 4 * (lane & 15);
        d[0] = v[i][0] * gs[i]; d[1] = v[i][1] * gs[i]; d[2] = v[i][2] * gs[i]; d[3] = v[i][3] * gs[i]; }
    asm volatile("s_waitcnt lgkmcnt(0)" ::: "memory");
    const int cc = lane & 7;
#pragma unroll
    for (int j = 0; j < 8; ++j) { const int n = (lane >> 3) + 8 * j; const LAS float* sp = scr + (8 * cc) * 65 + n;
        u32x4 o; o.x = cvt_pk_bf16(sp[0 * 65], sp[1 * 65]); o.y = cvt_pk_bf16(sp[2 * 65], sp[3 * 65]); o.z = cvt_pk_bf16(sp[4 * 65], sp[5 * 65]); o.w = cvt_pk_bf16(sp[6 * 65], sp[7 * 65]);
        *(u32x4*)(c.dst + (size_t)n * c.K + 8 * cc) = o; }
    asm volatile("s_waitcnt lgkmcnt(0)" ::: "memory");
}
__device__ __forceinline__ void convert_weights(const Args& a, LAS unsigned char* lds, int l, int it_lo, int it_hi, int w, int NW, int wave, int lane) {
    LAS float* scr = (LAS float*)(lds + wave * 16640);
    int it = it_lo + w; if (it >= it_hi) return;
    ConvItem cur = conv_decode(a, l, it); f32x4 v[16]; float gs[16];
    conv_issue(cur, v, gs, lane);
#pragma unroll 1
    for (;;) {
        const int nx = it + NW; const bool more = nx < it_hi;
        ConvItem nxt = cur; f32x4 v2[16]; float gs2[16];
        if (more) { nxt = conv_decode(a, l, nx); conv_issue(nxt, v2, gs2, lane); }
        __builtin_amdgcn_sched_barrier(0);
        conv_finish(cur, v, gs, scr, lane);
        if (!more) break;
        cur = nxt; it = nx;
#pragma unroll
        for (int i = 0; i < 16; ++i) { v[i] = v2[i]; gs[i] = gs2[i]; }
    }
}

__device__ __forceinline__ void prologue(const Args& a, LAS unsigned char* lds, int gw, int NGW, int wave, int lane, int nlayers) {
    unsigned char* ws = as_global(a.ws);
    float* outp = as_global(a.out);
    if (nlayers < 0) convert_weights(a, lds, 0, 0, I_GU, gw, NGW, wave, lane);
    else
#pragma unroll 1
    for (int l = 0; l < nlayers; ++l) convert_weights(a, lds, l, 0, I_LAYER, gw, NGW, wave, lane);
    i64* stats = (i64*)(ws + WS_STATS);
    for (int m = gw; m < MTOK; m += NGW) {
        const f32x4* xr = (const f32x4*)(as_global(a.in[0]) + (size_t)m * DM) + lane;
        u32x2* xb = (u32x2*)((bf16_t*)(ws + WS_XB) + (size_t)m * DM) + lane;
        float s = 0.f; f32x4 xin[4];
#pragma unroll
        for (int j = 0; j < 4; ++j) xin[j] = xr[64 * j];
#pragma unroll
        for (int j = 0; j < 4; ++j) { const f32x4 v = xin[j]; s += (v[0] * v[0] + v[1] * v[1]) + (v[2] * v[2] + v[3] * v[3]);
            u32x2 w; w.x = cvt_pk_bf16(v[0], v[1]); w.y = cvt_pk_bf16(v[2], v[3]); xb[64 * j] = w; }
        s = wave_sum(s);
        if (lane == 0) stats[m] = (i64)(s * FX);
    }
    { const int gt = gw * 64 + lane, NGT = NGW * 64;
      for (int i = gt; i < (NSLOT - 1) * MTOK / 2; i += NGT) ((f32x4*)(stats + MTOK))[i] = (f32x4){0.f, 0.f, 0.f, 0.f};
      float* rc = (float*)(ws + WS_ROT); float* rsn = rc + SEQ * 8;
      for (int i = gt; i < SEQ * 8; i += NGT) { const int pos = i >> 3, j = i & 7;
          const float inv = exp2f(-(float)j * 2.36644607116552f);
          const float ang = (float)pos * inv;
          const double rev = (double)ang * 0.15915494309189535; const float fr_ = (float)(rev - floor(rev));
          rc[i] = __builtin_amdgcn_cosf(fr_); rsn[i] = __builtin_amdgcn_sinf(fr_); }
      bf16_t* sw = (bf16_t*)(ws + WS_SGUW);
      for (int i = gt; i < DEPTH * 4 * 128 * 128 / 4; i += NGT) { const f32x4 v = ((const f32x4*)as_global(a.in[9]))[i]; u32x2 w; w.x = cvt_pk_bf16(v[0], v[1]); w.y = cvt_pk_bf16(v[2], v[3]); ((u32x2*)sw)[i] = w; }
    }
}

constexpr int OP = 68;
constexpr int ABLK = 512;
__device__ __forceinline__ void attn_unit(LAS unsigned char* lds, int b, int h, int blk, const bf16_t* Q, const bf16_t* Kb, const bf16_t* Vt1, const bf16_t* Vt4, const bf16_t* Vt16,
                                          bf16_t* MIX, i64* ssq_a, int wid, int lane_in) {
    int lane = lane_in; asm volatile("" : "+v"(lane));
    LAS float* Oacc = (LAS float*)lds; LAS float* Ml = Oacc + ABLK * OP;
    const int qi = lane & 15, kq = lane >> 4, T0 = blk * ABLK;
    const size_t tb = (size_t)b * SEQ; const size_t bhb = (size_t)(b * 8 + h) * (SEQ * 64);
#pragma unroll 1
    for (int p = 0; p < 3; ++p) {
        const int lg = 2 * p, L = SEQ >> lg;
        const bf16_t* Vt = p == 0 ? Vt1 : (p == 1 ? Vt4 : Vt16);
#pragma unroll 1
        for (int it = 0; it < 2; ++it) {
            const int pi = wid * 2 + it;
            int r, n0;
            if (p == 0) { r = 0; n0 = T0 + 32 * pi; } else if (p == 1) { r = pi >> 2; n0 = (T0 >> 2) + 32 * (pi & 3); } else { r = pi; n0 = T0 >> 4; }
            const int ws_ = n0 - 64;
            int qtok[2]; bf16x8 qf[2][2];
#pragma unroll
            for (int g = 0; g < 2; ++g) { qtok[g] = ((n0 + 16 * g + qi) << lg) + r; const bf16_t* qp = Q + bhb + (size_t)qtok[g] * 64 + kq * 16; qf[g][0] = *(const bf16x8*)qp; qf[g][1] = *(const bf16x8*)(qp + 8); }
            bf16x8 kf[10][2];
#pragma unroll
            for (int t = 0; t < 10; ++t) {
                const int widx = 32 * (t >> 1) + 8 * (qi >> 2) + 4 * (t & 1) + (qi & 3);
                int kn = ws_ + widx; kn = kn < 0 ? 0 : (kn > L - 1 ? L - 1 : kn);
                const bf16_t* kp = Kb + bhb + (size_t)((kn << lg) + r) * 64 + kq * 16;
                kf[t][0] = *(const bf16x8*)kp; kf[t][1] = *(const bf16x8*)(kp + 8);
            }
            __builtin_amdgcn_sched_barrier(0);
            f32x4 s[2][10];
#pragma unroll
            for (int t = 0; t < 10; ++t)
#pragma unroll
                for (int g = 0; g < 2; ++g) {
                    f32x4 z = (f32x4){0.f, 0.f, 0.f, 0.f};
                    z = __builtin_amdgcn_mfma_f32_16x16x32_bf16(kf[t][0], qf[g][0], z, 0, 0, 0);
                    z = __builtin_amdgcn_mfma_f32_16x16x32_bf16(kf[t][1], qf[g][1], z, 0, 0, 0);
                    s[g][t] = z;
                }
            __builtin_amdgcn_sched_barrier(0);
            bf16x8 vf[5][4];
#pragma unroll
            for (int c = 0; c < 5; ++c) {
                int gk = ws_ + 32 * c + 8 * kq; gk = (gk < 0 || gk >= L) ? 0 : gk;
                const bf16_t* vp = Vt + bhb + ((size_t)(r * (L >> 3) + (gk >> 3)) * 64 + qi) * 8;
#pragma unroll
                for (int dt = 0; dt < 4; ++dt) vf[c][dt] = *(const bf16x8*)(vp + dt * 128);
            }
            __builtin_amdgcn_sched_barrier(0);
            float mx[2], lsum[2];
#pragma unroll
            for (int g = 0; g < 2; ++g) {
                float m_ = -1e30f;
                int lo = 16 * g + qi, hi = 128 + 16 * g + qi; lo = lo > -ws_ ? lo : -ws_; hi = hi < L - 1 - ws_ ? hi : L - 1 - ws_;
                const int lo8 = lo - 8 * kq; const unsigned span = (unsigned)(hi - lo);
#pragma unroll
                for (int t = 0; t < 10; ++t)
#pragma unroll
                    for (int i = 0; i < 4; ++i) {
                        const int c = 32 * (t >> 1) + 4 * (t & 1) + i;
                        const bool ok = (unsigned)(c - lo8) <= span;
                        const float v = ok ? s[g][t][i] : -1e30f; s[g][t][i] = v; m_ = fmaxf(m_, v);
                    }
                m_ = fmaxf(m_, __shfl_xor(m_, 16)); m_ = fmaxf(m_, __shfl_xor(m_, 32));
                float l_ = 0.f;
#pragma unroll
                for (int t = 0; t < 10; ++t)
#pragma unroll
                    for (int i = 0; i < 4; ++i) { const float pv = __builtin_amdgcn_exp2f(s[g][t][i] - m_); s[g][t][i] = pv; l_ += pv; }
                l_ += __shfl_xor(l_, 16); l_ += __shfl_xor(l_, 32);
                mx[g] = m_; lsum[g] = l_;
            }
            f32x4 o[2][4];
#pragma unroll
            for (int g = 0; g < 2; ++g)
#pragma unroll
                for (int dt = 0; dt < 4; ++dt) o[g][dt] = (f32x4){0.f, 0.f, 0.f, 0.f};
#pragma unroll
            for (int c = 0; c < 5; ++c)
#pragma unroll
                for (int g = 0; g < 2; ++g) {
                    union { u32x4 u; bf16x8 v; } pf;
                    pf.u.x = cvt_pk_bf16(s[g][2 * c][0], s[g][2 * c][1]); pf.u.y = cvt_pk_bf16(s[g][2 * c][2], s[g][2 * c][3]);
                    pf.u.z = cvt_pk_bf16(s[g][2 * c + 1][0], s[g][2 * c + 1][1]); pf.u.w = cvt_pk_bf16(s[g][2 * c + 1][2], s[g][2 * c + 1][3]);
#pragma unroll
                    for (int dt = 0; dt < 4; ++dt) o[g][dt] = __builtin_amdgcn_mfma_f32_16x16x32_bf16(vf[c][dt], pf.v, o[g][dt], 0, 0, 0);
                }
#pragma unroll
            for (int g = 0; g < 2; ++g) {
                const int tl = qtok[g] - T0;
                LAS float* orow = Oacc + tl * OP + 4 * kq;
                if (p == 0) {
#pragma unroll
                    for (int dt = 0; dt < 4; ++dt) *(LAS f32x4*)(orow + 16 * dt) = o[g][dt];
                    if (kq == 0) { Ml[2 * tl] = mx[g]; Ml[2 * tl + 1] = lsum[g]; }
                } else {
                    const float mo = Ml[2 * tl], lo = Ml[2 * tl + 1];
                    const float mn = fmaxf(mo, mx[g]), fa = __builtin_amdgcn_exp2f(mo - mn), fb = __builtin_amdgcn_exp2f(mx[g] - mn);
                    f32x4 om[4];
#pragma unroll
                    for (int dt = 0; dt < 4; ++dt) om[dt] = *(const LAS f32x4*)(orow + 16 * dt) * fa + o[g][dt] * fb;
                    const float ln = lo * fa + lsum[g] * fb;
                    asm volatile("s_waitcnt lgkmcnt(0)" ::: "memory");
#pragma unroll
                    for (int dt = 0; dt < 4; ++dt) *(LAS f32x4*)(orow + 16 * dt) = om[dt];
                    if (kq == 0) { Ml[2 * tl] = mn; Ml[2 * tl + 1] = ln; }
                }
            }
        }
        __syncthreads();
    }
#pragma unroll 1
    for (int ps = 0; ps < ABLK / 256; ++ps) {
      const int tid = wid * 64 + lane, tl = ps * 256 + (tid >> 1), half = tid & 1;
      const float inv = 1.0f / Ml[2 * tl + 1]; const LAS float* orow = Oacc + tl * OP + 32 * half; float part = 0.f;
      bf16_t* op = MIX + (tb + T0 + tl) * DM + h * 64 + 32 * half;
#pragma unroll
      for (int j = 0; j < 4; ++j) { const f32x4 va = *(const LAS f32x4*)(orow + 8 * j) * inv, vb = *(const LAS f32x4*)(orow + 8 * j + 4) * inv;
          part += (va[0] * va[0] + va[1] * va[1]) + (va[2] * va[2] + va[3] * va[3]) + (vb[0] * vb[0] + vb[1] * vb[1]) + (vb[2] * vb[2] + vb[3] * vb[3]);
          u32x4 w; w.x = cvt_pk_bf16(va[0], va[1]); w.y = cvt_pk_bf16(va[2], va[3]); w.z = cvt_pk_bf16(vb[0], vb[1]); w.w = cvt_pk_bf16(vb[2], vb[3]); *(u32x4*)(op + 8 * j) = w; }
      part += __shfl_xor(part, 1);
      if (half == 0) fx_add(ssq_a + tb + T0 + tl, part);
    }
    __syncthreads();
}

constexpr int SGU_TAB = 131072;
__device__ __forceinline__ void sgu_unit(LAS unsigned char* lds, int tok0, const bf16_t* Gt, const bf16_t* U, const bf16_t* Wb, const float* bs, const float* lng, const float* lnb,
                                         const i64* lnsum, const i64* lnsq, bf16_t* MIX, int wid, int lane_in) {
    int lane = lane_in; asm volatile("" : "+v"(lane));
    LAS float* MU = (LAS float*)(lds + SGU_TAB); LAS float* RS = MU + 128; LAS float* SS = RS + 128;
    const int tid = wid * 64 + lane;
#pragma unroll
    for (int i = 0; i < 16; ++i) { const int P = ((i * 8 + wid) << 6) + lane, row = P >> 4, piece = (P & 15) ^ (row & 15);
        __builtin_amdgcn_global_load_lds((const unsigned*)(Wb + (size_t)row * 128 + piece * 8), (LAS unsigned*)(lds + (i * 8 + wid) * 1024), 16, 0, 0); }
    const int g = wid >> 1, e0 = 64 * (wid & 1), li = lane & 15, kq = lane >> 4;
    float gg[4], gb[4]; u32x4 rawg[4][4];
#pragma unroll
    for (int et = 0; et < 4; ++et) { const int ch = g * 128 + e0 + 16 * (li >> 2) + 4 * et + (li & 3);
        gg[et] = lng[ch]; gb[et] = lnb[ch];
#pragma unroll
        for (int c = 0; c < 4; ++c) rawg[c][et] = *(const u32x4*)(Gt + ((size_t)((tok0 + 32 * c + 8 * kq) >> 3) * 512 + ch) * 8); }
    if (tid < 128) { const float sm = fx_get(lnsum + tok0 + tid) * (1.0f / DH); const float var = fx_get(lnsq + tok0 + tid) * (1.0f / DH) - sm * sm;
        MU[tid] = sm; RS[tid] = __builtin_amdgcn_rsqf(fmaxf(var, 0.f) + EPS); }
    asm volatile("s_waitcnt vmcnt(0)" ::: "memory");
    __syncthreads();
    f32x4 acc[4][8];
#pragma unroll
    for (int et = 0; et < 4; ++et)
#pragma unroll
        for (int tt = 0; tt < 8; ++tt) acc[et][tt] = (f32x4){0.f, 0.f, 0.f, 0.f};
    const LAS unsigned char* wrow = lds + (size_t)(g * 128 + li) * 256;
#pragma unroll
    for (int c = 0; c < 4; ++c) {
        const int s0 = 32 * c + 8 * kq;
        const f32x4 mu0 = *(const LAS f32x4*)(MU + s0), mu1 = *(const LAS f32x4*)(MU + s0 + 4), rs0 = *(const LAS f32x4*)(RS + s0), rs1 = *(const LAS f32x4*)(RS + s0 + 4);
        bf16x8 af[4];
#pragma unroll
        for (int et = 0; et < 4; ++et) {
            const u32x4 raw = rawg[c][et];
            f32x4 x0, x1;
            x0[0] = __uint_as_float(raw.x << 16); x0[1] = __uint_as_float(raw.x & 0xffff0000u); x0[2] = __uint_as_float(raw.y << 16); x0[3] = __uint_as_float(raw.y & 0xffff0000u);
            x1[0] = __uint_as_float(raw.z << 16); x1[1] = __uint_as_float(raw.z & 0xffff0000u); x1[2] = __uint_as_float(raw.w << 16); x1[3] = __uint_as_float(raw.w & 0xffff0000u);
            x0 = (x0 - mu0) * rs0 * gg[et] + gb[et]; x1 = (x1 - mu1) * rs1 * gg[et] + gb[et];
            union { u32x4 u; bf16x8 v; } pk;
            pk.u.x = cvt_pk_bf16(x0[0], x0[1]); pk.u.y = cvt_pk_bf16(x0[2], x0[3]); pk.u.z = cvt_pk_bf16(x1[0], x1[1]); pk.u.w = cvt_pk_bf16(x1[2], x1[3]);
            af[et] = pk.v;
        }
#pragma unroll
        for (int tt = 0; tt < 8; ++tt) {
            const bf16x8 wf = *(const LAS bf16x8*)(wrow + tt * 4096 + (((4 * c + kq) ^ li) << 4));
#pragma unroll
            for (int et = 0; et < 4; ++et) acc[et][tt] = __builtin_amdgcn_mfma_f32_16x16x32_bf16(af[et], wf, acc[et][tt], 0, 0, 0);
        }
    }
    u32x4 uraw[8][2]; float biasv[8];
#pragma unroll
    for (int tt = 0; tt < 8; ++tt) { biasv[tt] = bs[g * 128 + 16 * tt + li];
        const bf16_t* up = U + (size_t)(tok0 + 16 * tt + li) * DH + g * 128 + e0 + 16 * kq;
        uraw[tt][0] = *(const u32x4*)up; uraw[tt][1] = *(const u32x4*)(up + 8); }
    __builtin_amdgcn_sched_barrier(0);
#pragma unroll
    for (int tt = 0; tt < 8; ++tt) {
        const int t = 16 * tt + li; const float bias = biasv[tt]; float part = 0.f;
#pragma unroll
        for (int et = 0; et < 4; ++et) {
            const unsigned r0 = (et & 1) ? uraw[tt][et >> 1].z : uraw[tt][et >> 1].x, r1 = (et & 1) ? uraw[tt][et >> 1].w : uraw[tt][et >> 1].y;
            f32x4 uv; uv[0] = __uint_as_float(r0 << 16); uv[1] = __uint_as_float(r0 & 0xffff0000u); uv[2] = __uint_as_float(r1 << 16); uv[3] = __uint_as_float(r1 & 0xffff0000u);
            const f32x4 v = uv * (acc[et][tt] + bias); acc[et][tt] = v;
            part += (v[0] * v[0] + v[1] * v[1]) + (v[2] * v[2] + v[3] * v[3]);
        }
        part += __shfl_xor(part, 16); part += __shfl_xor(part, 32);
        if (kq == 0) SS[wid * 128 + t] = part;
    }
    __syncthreads();
#pragma unroll
    for (int tt = 0; tt < 8; ++tt) {
        const int t = 16 * tt + li; float tot = 0.f;
#pragma unroll
        for (int w8 = 0; w8 < 8; ++w8) tot += SS[w8 * 128 + t];
        const float rstd = __builtin_amdgcn_rsqf(tot * (1.0f / DH) + EPS);
        bf16_t* mp = MIX + (size_t)(tok0 + t) * DM + DH + g * 128 + e0 + 16 * kq;
#pragma unroll
        for (int eh = 0; eh < 2; ++eh) { const f32x4 va = acc[2 * eh][tt] * rstd, vb = acc[2 * eh + 1][tt] * rstd;
            u32x4 w; w.x = cvt_pk_bf16(va[0], va[1]); w.y = cvt_pk_bf16(va[2], va[3]); w.z = cvt_pk_bf16(vb[0], vb[1]); w.w = cvt_pk_bf16(vb[2], vb[3]); *(u32x4*)(mp + 8 * eh) = w; }
    }
    __syncthreads();
}

#define XB_TMO      128
#define XB_XCNT(j)  (256  + 64 * (j))
#define XB_XSUB(j)  (1280 + 64 * (j))
#define XB_XGEN(j)  (2304 + 64 * (j))
#define XB_TOP      3328
#define XB_TOPGEN   3392
#define XCD_BAR_WORDS 3456
#define XB_SPIN_CAP (1u << 18)

__device__ __forceinline__ unsigned xb_ld(unsigned* p)              { return __hip_atomic_load(p, __ATOMIC_RELAXED, __HIP_MEMORY_SCOPE_AGENT); }
__device__ __forceinline__ unsigned xb_add(unsigned* p, unsigned v) { return __hip_atomic_fetch_add(p, v, __ATOMIC_RELAXED, __HIP_MEMORY_SCOPE_AGENT); }
__device__ __forceinline__ unsigned xb_xcc_id() { return (unsigned)__builtin_amdgcn_s_getreg((3 << 11) | 20) & 0xFu; }
#define XB_SPIN(cond, bar) do { unsigned _sp = 0; while (cond) { __builtin_amdgcn_s_sleep(1); \
    if ((++_sp & 255u) == 0u) { if (xb_ld(&(bar)[XB_TMO])) break; if (_sp > XB_SPIN_CAP) { atomicAdd(&(bar)[XB_TMO], 1u); break; } } } } while (0)

struct XcdBarrier {
    unsigned* bar; unsigned x;
    volatile LAS unsigned* st;
};

__device__ __forceinline__ XcdBarrier xcd_barrier_post(unsigned* bar, volatile LAS unsigned* st) {
    XcdBarrier b; b.bar = bar; b.x = xb_xcc_id(); b.st = st;
    if (threadIdx.x == 0) (void)xb_add(&bar[XB_XCNT(b.x)], 1u);
    return b;
}
__device__ __forceinline__ void xcd_barrier_complete(unsigned* bar, unsigned x, unsigned& nloc, unsigned& nx) {
    const unsigned G = gridDim.x * gridDim.y * gridDim.z;
    unsigned sum, cnt, mine, sp = 0u;
    for (;;) {
        sum = 0u; cnt = 0u; mine = 0u;
#pragma unroll
        for (unsigned j = 0; j < 16; ++j) { const unsigned c = xb_ld(&bar[XB_XCNT(j)]); sum += c; cnt += (c > 0u) ? 1u : 0u; mine = (j == x) ? c : mine; }
        if (sum == G) break;
        __builtin_amdgcn_s_sleep(1);
        if ((++sp & 255u) == 0u) { if (xb_ld(&bar[XB_TMO])) break; if (sp > XB_SPIN_CAP) { atomicAdd(&bar[XB_TMO], 1u); break; } }
    }
    nloc = mine > 0u ? mine : 1u; nx = cnt > 0u ? cnt : 1u;
}

__device__ __forceinline__ void xcd_barrier(const XcdBarrier& b) {
    asm volatile("s_waitcnt vmcnt(0)" ::: "memory");
    __syncthreads();
    if (threadIdx.x == 0) {
        unsigned* bar = b.bar;
        __builtin_amdgcn_s_waitcnt(0);
        unsigned nloc = b.st[0], nx = b.st[1];
        if (nloc == 0u) { xcd_barrier_complete(bar, b.x, nloc, nx); b.st[0] = nloc; b.st[1] = nx; }
        const unsigned old = xb_add(&bar[XB_XSUB(b.x)], 1u);
        const unsigned gen = old / nloc;
        if (old + 1u == (gen + 1u) * nloc) {
            __builtin_amdgcn_fence(__ATOMIC_RELEASE, "agent");
            asm volatile("s_waitcnt vmcnt(0)" ::: "memory");
            const unsigned og = xb_add(&bar[XB_TOP], 1u);
            const unsigned tg = og / nx;
            if (og + 1u == (tg + 1u) * nx) xb_add(&bar[XB_TOPGEN], 1u);
            else XB_SPIN(xb_ld(&bar[XB_TOPGEN]) == tg, bar);
            __builtin_amdgcn_fence(__ATOMIC_ACQUIRE, "agent");
            xb_add(&bar[XB_XGEN(b.x)], 1u);
            asm volatile("s_waitcnt vmcnt(0)" ::: "memory");
        } else {
            XB_SPIN(xb_ld(&bar[XB_XGEN(b.x)]) == gen, bar);
            __builtin_amdgcn_fence(__ATOMIC_ACQUIRE, "agent");
            asm volatile("s_waitcnt vmcnt(0)" ::: "memory");
        }
    }
    __syncthreads();
}

constexpr int RSL_OFF = 131072, RSL_UNITS = 6;
template <bool BY_COL> __device__ __forceinline__ void stage_rstd(LAS unsigned char* lds, const pg8::StaticOrder& S, const i64* ssq) {
    LAS float* rsl = (LAS float*)(lds + RSL_OFF); const int tid = threadIdx.x;
#pragma unroll 1
    for (int i = 0; i < RSL_UNITS; ++i) { Unit u; if (!S.next(i, u)) break;
        if (tid < 256) rsl[i * 256 + tid] = __builtin_amdgcn_rsqf(fx_get(ssq + (BY_COL ? u.pn : u.pm) * 256 + tid) * (1.0f / DM) + EPS); }
    __syncthreads();
}

constexpr int PH_PER_LAYER = 7, N_PHASES = 1 + DEPTH * PH_PER_LAYER + 1;

__global__ void __launch_bounds__(NWAVES * 64, 2) fwd_kernel(Args a) {
    extern __shared__ __attribute__((aligned(16))) unsigned char lds_raw[];
    LAS unsigned char* lds = (LAS unsigned char*)lds_raw;
    const int G = gridDim.x, cu = blockIdx.x;
    const int lo = a.ph_lo, hi = a.ph_hi;
    const bool spread = (G == 256) && MK_ONE;
#define IDLE_CONVERT(slot) do { if (spread && cu >= 128) { __builtin_amdgcn_sched_barrier(0); int tid_ = threadIdx.x; asm volatile("" : "+v"(tid_) :: "memory"); const int wave_ = __builtin_amdgcn_readfirstlane(tid_ >> 6); \
        const int NW_ = 128 * NWAVES, w_ = (cu - 128) * NWAVES + wave_; \
        const int l1_ = l, lo1_ = (slot) == 0 ? 2 * I_GU : ((slot) == 1 ? I_LAYER - I_OUT : 2 * I_GU + I_D), n1_ = (slot) == 0 ? I_D : ((slot) == 1 ? I_OUT : I_D); \
        const int l2_ = (slot) == 2 ? l + 1 : l, lo2_ = (slot) == 0 ? 2 * I_GU + 2 * I_D : ((slot) == 1 ? I_GU : I_GU / 4), n2_ = (slot) == 0 ? I_INN + I_INS : ((slot) == 1 ? I_GU : I_GU - I_GU / 4); \
        convert_weights(a, lds, l1_, lo1_, lo1_ + n1_, w_, NW_, wave_, tid_ & 63); \
        if (l2_ < DEPTH) convert_weights(a, lds, l2_, lo2_, lo2_ + n2_, (w_ + NW_ - (n1_ % NW_)) % NW_, NW_, wave_, tid_ & 63); \
        if ((slot) == 0 && l + 1 < DEPTH) convert_weights(a, lds, l + 1, 0, I_GU / 4, (w_ + 2 * NW_ - ((n1_ + n2_) % NW_)) % NW_, NW_, wave_, tid_ & 63);     \
        __syncthreads(); } } while (0)
#if MK_ONE
    cg::grid_group grid = cg::this_grid();
    { volatile LAS unsigned* misc = (volatile LAS unsigned*)(lds + MISC_OFF); if (threadIdx.x < 32) misc[threadIdx.x] = 0u; __syncthreads(); }
    XcdBarrier bar; bar.bar = (unsigned*)(as_global(a.ws) + WS_BAR); bar.x = xb_xcc_id(); bar.st = (volatile LAS unsigned*)(lds + MISC_OFF) + 8;
#define SEAM(k) do { if ((k) + 1 < hi) { if ((k) == 0) grid.sync(); else { xcd_barrier(bar); if (DUP & 4) xcd_barrier(bar); } } } while (0)
#else
#define SEAM(k) do { } while (0)
#endif
#define IN(k) (lo <= (k) && (k) < hi)
#define WSBASE() GAS unsigned char* wsg_ = (GAS unsigned char*)a.ws; asm volatile("" : "+s"(wsg_)); unsigned char* ws = (unsigned char*)wsg_; i64* stats = (i64*)(ws + WS_STATS); i64* st = stats + (size_t)(6 * l) * MTOK; unsigned char* wl = ws + WS_W + (size_t)l * WL_STRIDE; (void)st; (void)wl

    if (!(SKIP & 32) && IN(0)) {
        const int tid = threadIdx.x, lane = tid & 63, wave = __builtin_amdgcn_readfirstlane(tid >> 6);
        prologue(a, lds, cu * NWAVES + wave, G * NWAVES, wave, lane, spread ? -1 : DEPTH); __syncthreads();
        if (DUP & 8) { prologue(a, lds, cu * NWAVES + wave, G * NWAVES, wave, lane, spread ? -1 : DEPTH); __syncthreads(); }
#if MK_ONE
        if (cu == 0) { unsigned* bw = (unsigned*)(as_global(a.ws) + WS_BAR); for (int i = tid; i < (int)(BAR_BYTES / 4); i += NWAVES * 64) bw[i] = 0u; }
        grid.sync();
        if (tid == 0) (void)xb_add(&bar.bar[XB_XCNT(bar.x)], 1u);
#endif
    }

#pragma unroll 1
    for (int l = 0; l < DEPTH; ++l) {
        const int pb = 1 + l * PH_PER_LAYER;
#pragma unroll 1
        for (int f = 0; f < 2; ++f) {
            const int p0 = pb + (f ? 5 : 0);
            if (!(SKIP & 1) && IN(p0)) {
                WSBASE();
                pg8::Gemm g{(const bf16_t*)(ws + WS_XB), (const bf16_t*)(wl + (f ? WL_GU2 : WL_GU1)), MTOK, NGU, DM}; pg8::StaticOrder S; S.init(MTOK, NGU, G, cu);
                stage_rstd<false>(lds, S, st + (f ? 5 : 0) * MTOK);
                EpiSwiGLU E{(bf16_t*)(ws + WS_H), (const LAS float*)(lds + RSL_OFF)};
                pg8::gemm_phase<EpiSwiGLU, pg8::StaticOrder, true>(lds, g, S, E);
                if (DUP & 32) pg8::gemm_phase<EpiSwiGLU, pg8::StaticOrder, true>(lds, g, S, E);
                if (DUP & 256) { EpiNull EN; pg8::gemm_phase<EpiNull, pg8::StaticOrder, true>(lds, g, S, EN); }
                IDLE_CONVERT(f ? 2 : 0);
                SEAM(p0);
            }
            if (!(SKIP & 64) && IN(p0 + 1)) {
                WSBASE();
                pg8::Gemm g{(const bf16_t*)(ws + WS_H), (const bf16_t*)(wl + (f ? WL_D2 : WL_D1)), MTOK, DM, DFF}; pg8::StaticOrder S; S.init(MTOK, DM, G, cu);
                if (FUSE_FINAL && l == DEPTH - 1 && f == 1 && G == 256) {
                    EpiFinal E{as_global(a.out), as_global(a.out), st + 6 * MTOK, (unsigned*)(stats + (size_t)25 * MTOK), as_global(a.in[18]), 0.5f};
                    pg8::gemm_phase<EpiFinal, pg8::StaticOrder, true>(lds, g, S, E);
                } else {
                    EpiResid<-1> E{(l == 0 && f == 0) ? as_global(a.in[0]) : (const float*)as_global(a.out), as_global(a.out), (bf16_t*)(ws + WS_XB), st + (f ? 6 : 1) * MTOK, nullptr, 0.5f};
                    pg8::gemm_phase<EpiResid<-1>, pg8::StaticOrder, true>(lds, g, S, E);
                    SEAM(p0 + 1);
                }
            }
            if (f == 1) break;
            if (!(SKIP & 2) && IN(pb + 2)) {
                { WSBASE();
                  pg8::Gemm g{(const bf16_t*)(ws + WS_XB), (const bf16_t*)(wl + WL_INN), MTOK, 1536, DM}; pg8::StaticOrder S; S.init(MTOK, 1536, G, cu);
                  stage_rstd<false>(lds, S, st + 1 * MTOK);
                  EpiQKU E{(bf16_t*)(ws + WS_Q), (const LAS float*)(lds + RSL_OFF), (const float*)(ws + WS_ROT), (const float*)(ws + WS_ROT) + SEQ * 8};
                  pg8::gemm_phase<EpiQKU, pg8::StaticOrder, true>(lds, g, S, E);
                  if (DUP & 16) pg8::gemm_phase<EpiQKU, pg8::StaticOrder, true>(lds, g, S, E); }
                { WSBASE();
                  pg8::Gemm g{(const bf16_t*)(wl + WL_INS), (const bf16_t*)(ws + WS_XB), 1024, MTOK, DM}; pg8::StaticOrder S; S.init(1024, MTOK, G, G - 1 - cu);
                  stage_rstd<true>(lds, S, st + 1 * MTOK);
                  EpiVG E{(bf16_t*)(ws + WS_VT1), (bf16_t*)(ws + WS_VT4), (bf16_t*)(ws + WS_VT16), (bf16_t*)(ws + WS_GT), (const LAS float*)(lds + RSL_OFF), st + 3 * MTOK, st + 4 * MTOK};
                  pg8::gemm_phase<EpiVG, pg8::StaticOrder, true>(lds, g, S, E);
                  if (DUP & 16) { EpiVG E2 = E; E2.lnsum = stats + (size_t)30 * MTOK; E2.lnsq = stats + (size_t)31 * MTOK; pg8::gemm_phase<EpiVG, pg8::StaticOrder, true>(lds, g, S, E2); } }
                IDLE_CONVERT(1);
                SEAM(pb + 2);
            }
            if (IN(pb + 3)) {
                const int tid = threadIdx.x, lane = tid & 63, wave = __builtin_amdgcn_readfirstlane(tid >> 6);
                if (!(SKIP & 4)) { WSBASE();
                  for (int u = cu; u < 256; u += G) { const int j = u >> 3, bh = (u & 7) * 2 + (j >> 4), blk = j & 15;
                    attn_unit(lds, bh >> 3, bh & 7, blk, (const bf16_t*)(ws + WS_Q), (const bf16_t*)(ws + WS_K), (const bf16_t*)(ws + WS_VT1), (const bf16_t*)(ws + WS_VT4), (const bf16_t*)(ws + WS_VT16),
                              (bf16_t*)(ws + WS_MIX), st + 2 * MTOK, wave, lane);
                    if (DUP & 1) attn_unit(lds, bh >> 3, bh & 7, blk, (const bf16_t*)(ws + WS_Q), (const bf16_t*)(ws + WS_K), (const bf16_t*)(ws + WS_VT1), (const bf16_t*)(ws + WS_VT4), (const bf16_t*)(ws + WS_VT16),
                              (bf16_t*)(ws + WS_MIX), stats + (size_t)30 * MTOK, wave, lane); } }
                if (!(SKIP & 8)) { WSBASE();
                  for (int u = cu; u < MTOK / 128; u += G) for (int rp = 0; rp < ((DUP & 2) ? 2 : 1); ++rp)
                    sgu_unit(lds, u * 128, (const bf16_t*)(ws + WS_GT), (const bf16_t*)(ws + WS_U), (const bf16_t*)(ws + WS_SGUW) + (size_t)l * 4 * 16384, as_global(a.in[10]) + l * 512, as_global(a.in[7]) + l * DH, as_global(a.in[8]) + l * DH,
                             st + 3 * MTOK, st + 4 * MTOK, (bf16_t*)(ws + WS_MIX), wave, lane); }
                SEAM(pb + 3);
            }
            if (!(SKIP & 16) && IN(pb + 4)) {
                WSBASE();
                pg8::Gemm g{(const bf16_t*)(ws + WS_MIX), (const bf16_t*)(wl + WL_OUT), MTOK, DM, DM}; pg8::StaticOrder S; S.init(MTOK, DM, G, cu);
                EpiResid<8> E{as_global(a.out), as_global(a.out), (bf16_t*)(ws + WS_XB), st + 5 * MTOK, st + 2 * MTOK, 1.0f};
                pg8::gemm_phase<EpiResid<8>, pg8::StaticOrder, true>(lds, g, S, E);
                SEAM(pb + 4);
            }
        }
    }
    if (IN(N_PHASES - 1) && !(FUSE_FINAL && G == 256)) {
        const int tid = threadIdx.x, lane = tid & 63, wave = __builtin_amdgcn_readfirstlane(tid >> 6);
        const i64* fs = (const i64*)(as_global(a.ws) + WS_STATS) + (size_t)24 * MTOK; const f32x4* gn = (const f32x4*)as_global(a.in[18]) + lane;
        for (int m = cu * NWAVES + wave; m < MTOK; m += G * NWAVES) {
            const float rs = __builtin_amdgcn_rsqf(fx_get(fs + m) * (1.0f / DM) + EPS);
            f32x4* xr = (f32x4*)(as_global(a.out) + (size_t)m * DM) + lane;
            f32x4 xv[4];
#pragma unroll
            for (int j = 0; j < 4; ++j) xv[j] = xr[64 * j] * gn[64 * j];
#pragma unroll
            for (int j = 0; j < 4; ++j) xr[64 * j] = xv[j] * rs;
        }
    }
#undef IN
#undef SEAM
#undef WSBASE
#undef IDLE_CONVERT
}

extern "C" void kernel_launch(void* const* d_in, const int* in_sizes, int n_in, void* d_out, int out_size, void* d_ws, size_t ws_size, hipStream_t stream) {
    static int grid = 0;
    if (grid == 0) {
        if (n_in != 19 || out_size != MTOK * DM || ws_size < WS_END) { fprintf(stderr, "kernel_launch: unexpected shapes (n_in %d out %d ws %zu); nothing launched\n", n_in, out_size, ws_size); grid = -1; return; }
        int dev = 0, cus = 0, per_cu = 0;
        hipGetDevice(&dev); hipDeviceGetAttribute(&cus, hipDeviceAttributeMultiprocessorCount, dev);
        if (hipFuncSetAttribute((const void*)fwd_kernel, hipFuncAttributeMaxDynamicSharedMemorySize, LDS_BYTES) != hipSuccess) { fprintf(stderr, "kernel_launch: hipFuncSetAttribute failed\n"); grid = -1; return; }
        hipOccupancyMaxActiveBlocksPerMultiprocessor(&per_cu, (const void*)fwd_kernel, NWAVES * 64, LDS_BYTES);
        (void)hipGetLastError();
        if (per_cu < 1) fprintf(stderr, "kernel_launch: occupancy query says %d blocks per CU\n", per_cu);
        grid = cus > 0 ? cus : 256;
    }
    if (grid < 0) return;
    Args a{};
    for (int i = 0; i < 19; ++i) a.in[i] = (const float*)d_in[i];
    a.out = (float*)d_out; a.ws = (unsigned char*)d_ws;
#if MK_ONE
    a.ph_lo = 0; a.ph_hi = N_PHASES;
    void* args[] = {&a};
    hipError_t e = hipLaunchCooperativeKernel((const void*)fwd_kernel, dim3(grid), dim3(NWAVES * 64), args, LDS_BYTES, stream);
    if (e != hipSuccess) fprintf(stderr, "cooperative launch failed: %s (grid %d)\n", hipGetErrorString(e), grid);
#else
    for (int p = 0; p < N_PHASES; ++p) { a.ph_lo = p; a.ph_hi = p + 1; hipLaunchKernelGGL(fwd_kernel, dim3(grid), dim3(NWAVES * 64), LDS_BYTES, stream, a); }
#endif
}
```
